# Optimizing an MI355X kernel written in HIP

```python
import jax, jax.numpy as jnp
from jax import lax
import numpy as np

D_MODEL = 1024
BATCH = 16
SEQ = 256
DEPTH = 2
DEC_BATCH = 2
DEC_SEQ = 4096
PAST_LEN = 512

GRID_W = 64
N_ADA = 6
D_FF = 4 * D_MODEL
EPS = 1e-6
NEG_INF = -1e30
Q_BLOCK = 128
ROPE_THETA = 10000.0
POOL_WIDTH = D_MODEL // 2
POOL_WINDOWS = (2, 4, 8, 16)
N_POOL_GROUPS = len(POOL_WINDOWS)
POOL_GROUP = POOL_WIDTH // N_POOL_GROUPS
MLA_HEADS = 8
MLA_NOPE = 64
MLA_ROPE = 32
MLA_QK = MLA_NOPE + MLA_ROPE
MLA_V = 64
Q_LORA = 256
KV_LORA = 128
SPLIT0 = (POOL_WIDTH, POOL_WIDTH + Q_LORA, POOL_WIDTH + Q_LORA + KV_LORA)
IN0_WIDTH = POOL_WIDTH + Q_LORA + KV_LORA + MLA_ROPE
OUT0_WIDTH = POOL_WIDTH + MLA_HEADS * MLA_V
NA_HEADS = 16
NA_HEAD_DIM = D_MODEL // NA_HEADS
NA_KH = 8
NA_KW = 16

kernel_name = "hybrid_pool_mla_natten_diffusion_step"


def rms_norm(x, w):
    xf = x.astype(jnp.float32)
    y = xf * lax.rsqrt(jnp.mean(xf * xf, axis=-1, keepdims=True) + EPS)
    return (y * w.astype(jnp.float32)).astype(x.dtype)


def ada_modulation(cond, w_ada, b_ada):
    m = jax.nn.silu(cond) @ w_ada + b_ada
    return jnp.split(m[:, None, :], N_ADA, axis=-1)


def modulate(x, norm_w, shift, scale):
    return rms_norm(x, norm_w) * (1 + scale) + shift


def channel_mixer(h, w1, w2):
    return jnp.square(jax.nn.relu(h @ w1)) @ w2


def axial_rope(x):
    S = x.shape[1]
    t = jnp.arange(S)
    half = x.shape[-1] // 2
    inv_freq = jnp.power(ROPE_THETA, -jnp.arange(0, half, 2, dtype=jnp.float32) / half)
    xf = x.astype(jnp.float32)

    def rotate(xa, pos):
        ang = pos.astype(jnp.float32)[:, None] * inv_freq[None, :]
        cos = jnp.cos(ang)[None, :, None, :]
        sin = jnp.sin(ang)[None, :, None, :]
        x1, x2 = xa[..., : half // 2], xa[..., half // 2:]
        return jnp.concatenate([x1 * cos - x2 * sin, x1 * sin + x2 * cos], axis=-1)

    y = jnp.concatenate([rotate(xf[..., :half], t // GRID_W), rotate(xf[..., half:], t % GRID_W)], axis=-1)
    return y.astype(x.dtype)


def blocked_attention(q, k, v, scale):
    B, S, H, Dq = q.shape
    nblk = S // Q_BLOCK
    qb = jnp.moveaxis(q.reshape(B, nblk, Q_BLOCK, H, Dq), 1, 0)

    def one_block(qblk):
        s = jnp.einsum('bqhd,bkhd->bhqk', qblk, k, preferred_element_type=jnp.float32) * scale
        p = jax.nn.softmax(s, axis=-1).astype(v.dtype)
        return jnp.einsum('bhqk,bkhd->bqhd', p, v)

    out = lax.map(one_block, qb)
    return jnp.moveaxis(out, 0, 1).reshape(B, S, H, v.shape[-1])


def pool_mixer(u, w_pool, pool_scale):
    B, S, _ = u.shape
    ug = u.astype(jnp.float32).reshape(B, S, N_POOL_GROUPS, POOL_GROUP)
    cs = jnp.concatenate([jnp.zeros((B, 1, N_POOL_GROUPS, POOL_GROUP), jnp.float32), jnp.cumsum(ug, axis=1)], axis=1)
    t = jnp.arange(S)
    outs = []
    for g, win in enumerate(POOL_WINDOWS):
        lo = jnp.clip(t - win // 2, 0, S)
        hi = jnp.clip(t - win // 2 + win, 0, S)
        csg = cs[:, :, g]
        mean = (csg[:, hi] - csg[:, lo]) / (hi - lo).astype(jnp.float32)[None, :, None]
        outs.append(mean - ug[:, :, g])
    pooled = jnp.stack(outs, axis=2)
    mixed = jnp.einsum('bsgc,gcd->bsgd', pooled, w_pool.astype(jnp.float32))
    return (mixed.reshape(B, S, POOL_WIDTH) * pool_scale.astype(jnp.float32)).astype(u.dtype)


def mla_split(h, w_in, q_lora_norm, kv_lora_norm, w_q_up, mla_q_norm):
    B, S, _ = h.shape
    a_in, q_lat, kv_lat, k_rope = jnp.split(h @ w_in, SPLIT0, axis=-1)
    q = (rms_norm(q_lat, q_lora_norm) @ w_q_up).reshape(B, S, MLA_HEADS, MLA_QK)
    q = rms_norm(q, mla_q_norm)
    ckv = rms_norm(kv_lat, kv_lora_norm)
    return a_in, q, ckv, k_rope


def mla_keys_values(ckv, k_rope, w_kv_up, mla_k_norm):
    B, L, _ = ckv.shape
    kv = (ckv @ w_kv_up).reshape(B, L, MLA_HEADS, MLA_NOPE + MLA_V)
    k_nope, v = kv[..., :MLA_NOPE], kv[..., MLA_NOPE:]
    k = jnp.concatenate([k_nope, jnp.broadcast_to(k_rope[:, :, None, :], (B, L, MLA_HEADS, MLA_ROPE))], axis=-1)
    return rms_norm(k, mla_k_norm), v


def rope_tail(x):
    return jnp.concatenate([x[..., :MLA_NOPE], axial_rope(x[..., MLA_NOPE:])], axis=-1)


def pool_mla_context(h, w_in, q_lora_norm, kv_lora_norm, w_q_up, w_kv_up, mla_q_norm, mla_k_norm,
                     w_pool, pool_scale, w_out):
    B, S, _ = h.shape
    a_in, q, ckv, k_rope = mla_split(h, w_in, q_lora_norm, kv_lora_norm, w_q_up, mla_q_norm)
    k, v = mla_keys_values(ckv, k_rope, w_kv_up, mla_k_norm)
    attn = blocked_attention(q, k, v, MLA_QK ** -0.5).reshape(B, S, MLA_HEADS * MLA_V)
    out = jnp.concatenate([pool_mixer(a_in, w_pool, pool_scale), attn], axis=-1) @ w_out
    return out, ckv, k_rope


def pool_mla_latent(h, ckv_ctx, krope_ctx, w_in, q_lora_norm, kv_lora_norm, w_q_up, w_kv_up, mla_q_norm,
                    mla_k_norm, w_pool, pool_scale, w_out):
    B, S, _ = h.shape
    a_in, q, ckv, k_rope = mla_split(h, w_in, q_lora_norm, kv_lora_norm, w_q_up, mla_q_norm)
    k_lat, v_lat = mla_keys_values(ckv, k_rope, w_kv_up, mla_k_norm)
    k_ctx, v_ctx = mla_keys_values(ckv_ctx, krope_ctx, w_kv_up, mla_k_norm)
    q = rope_tail(q)
    k = jnp.concatenate([rope_tail(k_lat), k_ctx], axis=1)
    v = jnp.concatenate([v_lat, v_ctx], axis=1)
    attn = blocked_attention(q, k, v, MLA_QK ** -0.5).reshape(B, S, MLA_HEADS * MLA_V)
    return jnp.concatenate([pool_mixer(a_in, w_pool, pool_scale), attn], axis=-1) @ w_out


def na_qkv(h, w_in, na_q_norm, na_k_norm):
    B, S, _ = h.shape
    q, k, v = jnp.split(h @ w_in, 3, axis=-1)
    shp = (B, S, NA_HEADS, NA_HEAD_DIM)
    return rms_norm(q.reshape(shp), na_q_norm), rms_norm(k.reshape(shp), na_k_norm), v.reshape(shp)


def neighbourhood_attention(q, k, v, k_ctx, v_ctx, rel_bias):
    B, S, H, D = q.shape
    rows = S // GRID_W
    kh = min(NA_KH, rows)
    kw = NA_KW
    scale = D ** -0.5
    qg = q.reshape(B, rows, GRID_W, H, D)
    kg = k.reshape(B, rows, GRID_W, H, D)
    vg = v.reshape(B, rows, GRID_W, H, D)
    qcol = jnp.arange(GRID_W)
    kcol = jnp.arange(GRID_W)
    col_start = jnp.clip(qcol - kw // 2, 0, GRID_W - kw)
    col_mask = (kcol[None, :] >= col_start[:, None]) & (kcol[None, :] < col_start[:, None] + kw)
    dc_idx = jnp.clip(kcol[None, :] - qcol[:, None] + NA_KW - 1, 0, 2 * NA_KW - 2)
    bias_cols = rel_bias.astype(jnp.float32)[:, :, dc_idx]

    def one_row(r):
        rs = jnp.clip(r - kh // 2, 0, rows - kh)
        kb = lax.dynamic_slice_in_dim(kg, rs, kh, axis=1)
        vb = lax.dynamic_slice_in_dim(vg, rs, kh, axis=1)
        qr = lax.dynamic_index_in_dim(qg, r, axis=1, keepdims=False)
        dr_idx = rs + jnp.arange(kh) - r + NA_KH - 1
        bias = jnp.take(bias_cols, dr_idx, axis=1)
        bias = jnp.where(col_mask[None, None], bias, NEG_INF).transpose(0, 2, 1, 3)
        s_loc = jnp.einsum('bqhd,bikhd->bhqik', qr, kb, preferred_element_type=jnp.float32) * scale + bias[None]
        s_ctx = jnp.einsum('bqhd,blhd->bhql', qr, k_ctx, preferred_element_type=jnp.float32) * scale
        s = jnp.concatenate([s_loc.reshape(B, H, GRID_W, kh * GRID_W), s_ctx], axis=-1)
        p = jax.nn.softmax(s, axis=-1).astype(v.dtype)
        p_loc = p[..., : kh * GRID_W].reshape(B, H, GRID_W, kh, GRID_W)
        p_ctx = p[..., kh * GRID_W:]
        return (jnp.einsum('bhqik,bikhd->bqhd', p_loc, vb)
                + jnp.einsum('bhql,blhd->bqhd', p_ctx, v_ctx))

    out = lax.map(one_row, jnp.arange(rows))
    return jnp.moveaxis(out, 0, 1).reshape(B, S, H, D)


def na_context(h, w_in, na_q_norm, na_k_norm, w_out):
    B, S, _ = h.shape
    q, k, v = na_qkv(h, w_in, na_q_norm, na_k_norm)
    attn = blocked_attention(q, k, v, NA_HEAD_DIM ** -0.5).reshape(B, S, D_MODEL)
    return attn @ w_out, k, v


def na_latent(h, k_ctx, v_ctx, w_in, na_q_norm, na_k_norm, rel_bias, w_out):
    B, S, _ = h.shape
    q, k, v = na_qkv(h, w_in, na_q_norm, na_k_norm)
    attn = neighbourhood_attention(q, k, v, k_ctx, v_ctx, rel_bias).reshape(B, S, D_MODEL)
    return attn @ w_out


def setup_inputs(seed: int = 0) -> dict:
    key = jax.random.key(seed)
    keys = jax.random.split(key, 48)
    counter = [0]

    def nk():
        counter[0] += 1
        return keys[counter[0] - 1]

    def nrm(shape, s=1.0):
        return s * jax.random.normal(nk(), shape, jnp.float32)

    def dense(shape, fan_in, s=1.0):
        return nrm(shape, s * fan_in ** -0.5)

    def gain(shape):
        return 1.0 + nrm(shape, 0.05)

    return {
        "x_prompt": nrm((BATCH, SEQ, D_MODEL)),
        "x_sample": nrm((DEC_BATCH, DEC_SEQ, D_MODEL)),
        "cache_l0_mla_ckv": nrm((DEC_BATCH, PAST_LEN, KV_LORA)),
        "cache_l0_mla_krope": nrm((DEC_BATCH, PAST_LEN, MLA_ROPE)),
        "cache_l1_na_k": nrm((DEC_BATCH, PAST_LEN, NA_HEADS, NA_HEAD_DIM)),
        "cache_l1_na_v": nrm((DEC_BATCH, PAST_LEN, NA_HEADS, NA_HEAD_DIM)),
        "c": nrm((DEC_BATCH, D_MODEL)),
        "c_ctx": nrm((D_MODEL,)),
        "w_ada_l0": dense((D_MODEL, N_ADA * D_MODEL), D_MODEL, 0.5),
        "b_ada_l0": nrm((N_ADA * D_MODEL,), 0.02),
        "norm_mix_l0": gain((D_MODEL,)),
        "norm_mlp_l0": gain((D_MODEL,)),
        "w_mlp1_l0": dense((D_MODEL, D_FF), D_MODEL),
        "w_mlp2_l0": dense((D_FF, D_MODEL), D_FF),
        "w_in_l0": dense((D_MODEL, IN0_WIDTH), D_MODEL),
        "q_lora_norm_l0": gain((Q_LORA,)),
        "kv_lora_norm_l0": gain((KV_LORA,)),
        "w_q_up_l0": dense((Q_LORA, MLA_HEADS * MLA_QK), Q_LORA),
        "w_kv_up_l0": dense((KV_LORA, MLA_HEADS * (MLA_NOPE + MLA_V)), KV_LORA),
        "mla_q_norm_l0": gain((MLA_QK,)),
        "mla_k_norm_l0": gain((MLA_QK,)),
        "w_pool_l0": dense((N_POOL_GROUPS, POOL_GROUP, POOL_GROUP), POOL_GROUP),
        "pool_scale_l0": gain((POOL_WIDTH,)),
        "w_out_l0": dense((OUT0_WIDTH, D_MODEL), OUT0_WIDTH),
        "w_ada_l1": dense((D_MODEL, N_ADA * D_MODEL), D_MODEL, 0.5),
        "b_ada_l1": nrm((N_ADA * D_MODEL,), 0.02),
        "norm_mix_l1": gain((D_MODEL,)),
        "norm_mlp_l1": gain((D_MODEL,)),
        "w_mlp1_l1": dense((D_MODEL, D_FF), D_MODEL),
        "w_mlp2_l1": dense((D_FF, D_MODEL), D_FF),
        "w_in_l1": dense((D_MODEL, 3 * D_MODEL), D_MODEL),
        "na_q_norm_l1": gain((NA_HEAD_DIM,)),
        "na_k_norm_l1": gain((NA_HEAD_DIM,)),
        "rel_bias_l1": nrm((NA_HEADS, 2 * NA_KH - 1, 2 * NA_KW - 1), 0.2),
        "w_out_l1": dense((D_MODEL, D_MODEL), D_MODEL),
    }


def reference(x_prompt, x_sample, cache_l0_mla_ckv, cache_l0_mla_krope, cache_l1_na_k, cache_l1_na_v, c, c_ctx,
              w_ada_l0, b_ada_l0, norm_mix_l0, norm_mlp_l0, w_mlp1_l0, w_mlp2_l0,
              w_in_l0, q_lora_norm_l0, kv_lora_norm_l0, w_q_up_l0, w_kv_up_l0, mla_q_norm_l0, mla_k_norm_l0,
              w_pool_l0, pool_scale_l0, w_out_l0,
              w_ada_l1, b_ada_l1, norm_mix_l1, norm_mlp_l1, w_mlp1_l1, w_mlp2_l1,
              w_in_l1, na_q_norm_l1, na_k_norm_l1, rel_bias_l1, w_out_l1):
    ada_w = (w_ada_l0, w_ada_l1)
    ada_b = (b_ada_l0, b_ada_l1)
    norm_mix = (norm_mix_l0, norm_mix_l1)
    norm_mlp = (norm_mlp_l0, norm_mlp_l1)
    mlp1 = (w_mlp1_l0, w_mlp1_l1)
    mlp2 = (w_mlp2_l0, w_mlp2_l1)
    p0 = (w_in_l0, q_lora_norm_l0, kv_lora_norm_l0, w_q_up_l0, w_kv_up_l0, mla_q_norm_l0, mla_k_norm_l0,
          w_pool_l0, pool_scale_l0, w_out_l0)

    xp = x_prompt
    xs = x_sample
    new_state = []
    for i in range(DEPTH):
        sh1_p, sc1_p, g1_p, sh2_p, sc2_p, g2_p = ada_modulation(c_ctx[None, :], ada_w[i], ada_b[i])
        sh1_s, sc1_s, g1_s, sh2_s, sc2_s, g2_s = ada_modulation(c, ada_w[i], ada_b[i])
        hp = modulate(xp, norm_mix[i], sh1_p, sc1_p)
        hs = modulate(xs, norm_mix[i], sh1_s, sc1_s)
        if i % 2 == 0:
            mp, ckv_new, krope_new = pool_mla_context(hp, *p0)
            ms = pool_mla_latent(hs, cache_l0_mla_ckv, cache_l0_mla_krope, *p0)
            new_state += [ckv_new, krope_new]
        else:
            mp, k_new, v_new = na_context(hp, w_in_l1, na_q_norm_l1, na_k_norm_l1, w_out_l1)
            ms = na_latent(hs, cache_l1_na_k, cache_l1_na_v, w_in_l1, na_q_norm_l1, na_k_norm_l1,
                           rel_bias_l1, w_out_l1)
            new_state += [k_new, v_new]
        xp = xp + g1_p * mp
        xs = xs + g1_s * ms
        xp = xp + g2_p * channel_mixer(modulate(xp, norm_mlp[i], sh2_p, sc2_p), mlp1[i], mlp2[i])
        xs = xs + g2_s * channel_mixer(modulate(xs, norm_mlp[i], sh2_s, sc2_s), mlp1[i], mlp2[i])
    y_prompt = xp
    y_sample = xs
    return (y_prompt, y_sample, *new_state)
```

```cpp
#include <hip/hip_runtime.h>
#include <hip/hip_cooperative_groups.h>
#include <cstdio>
#include <cstdint>
namespace cg = cooperative_groups;

#define P0_PARTS 7
#define TR_MASK 0x7ff
#ifndef REP_ATT
#define REP_ATT 1
#endif
#ifndef REP_MLP1
#define REP_MLP1 1
#endif
#ifndef REP_EW
#define REP_EW 1
#endif
#ifndef REP_P0
#define REP_P0 1
#endif
#ifndef REP_SYNC
#define REP_SYNC 0
#endif
#ifndef MK_PER_PHASE
#define MK_PER_PHASE 0
#endif

namespace pg8 {
#define PG8_LAS __attribute__((address_space(3)))
typedef unsigned short bf16_t;
typedef short bf16x8 __attribute__((ext_vector_type(8)));
typedef float f32x4 __attribute__((ext_vector_type(4)));
typedef unsigned u32x4 __attribute__((ext_vector_type(4)));
constexpr int BM = 256, BK = 64, HALF = 128, HTB = HALF * BK * 2  , STAGE_BYTES = 8 * HTB, NXCD = 8, WGM = 8;

__host__ __device__ __forceinline__ int lds_byte(int r, int c) { const int st = (r >> 4) * 2 + (c >> 5), rr = r & 15, cc = c & 31, ob = rr * 64 + cc * 2; return st * 1024 + (ob ^ (((ob >> 9) & 1) << 5)); }
__host__ __device__ __forceinline__ void stage_rc(int b, int& R, int& C) { const int st = b / 1024, sb = b % 1024, swz = sb ^ (((sb >> 9) & 1) << 5); R = (st >> 1) * 16 + swz / 64; C = (st & 1) * 32 + (swz % 64) / 2; }
__host__ __device__ __forceinline__ int perm32(int rho) { const int n = rho >> 4, i = rho & 15; return 8 * (i >> 2) + 4 * n + (i & 3); }

struct Unit { int pm, pn; };
struct Gemm { const bf16_t* A; const bf16_t* Bt; int M, N, K; };

struct StaticOrder {
    int nM, nN, nwg, G, c;
    __host__ __device__ void init(int M, int N, int G_, int c_) { nM = M / BM; nN = N / BM; nwg = nM * nN; G = G_; c = c_; }
    __host__ __device__ bool next(int i, Unit& u) const {
        const long L = (long)i * G + c; if (L >= nwg) return false;
        int wgid = (int)L; { const int q = nwg / NXCD, r = nwg % NXCD, xcd = wgid % NXCD, off = wgid / NXCD; wgid = (xcd < r ? xcd * (q + 1) : r * (q + 1) + (xcd - r) * q) + off; }
        const int nig = WGM * nN, gid = wgid / nig, fm = gid * WGM, gsz = (nM - fm) < WGM ? (nM - fm) : WGM;
        u.pm = fm + ((wgid % nig) % gsz); u.pn = (wgid % nig) / gsz; return true;
    }
    __device__ __forceinline__ void a_ready(const Unit&) const {}
    __device__ __forceinline__ void done(const Unit&) const {}
};

typedef float f32x2 __attribute__((ext_vector_type(2)));
typedef __bf16 bf16x2v __attribute__((ext_vector_type(2)));
typedef unsigned u32x2v __attribute__((ext_vector_type(2)));
__device__ __forceinline__ unsigned pk2(float lo, float hi) { f32x2 v = {lo, hi}; bf16x2v r = __builtin_convertvector(v, bf16x2v); return __builtin_bit_cast(unsigned, r); }
typedef unsigned u32x2p __attribute__((ext_vector_type(2)));
__device__ __forceinline__ float xadd16(float x) { const unsigned u = __float_as_uint(x); const u32x2p r = __builtin_amdgcn_permlane16_swap(u, u, false, false); return __uint_as_float(r[0]) + __uint_as_float(r[1]); }
__device__ __forceinline__ float xadd32(float x) { const unsigned u = __float_as_uint(x); const u32x2p r = __builtin_amdgcn_permlane32_swap(u, u, false, false); return __uint_as_float(r[0]) + __uint_as_float(r[1]); }
__device__ __forceinline__ float xmax32(float x) { const unsigned u = __float_as_uint(x); const u32x2p r = __builtin_amdgcn_permlane32_swap(u, u, false, false); return fmaxf(__uint_as_float(r[0]), __uint_as_float(r[1])); }
__device__ __forceinline__ float dpp_xadd1(float x) { return x + __uint_as_float(__builtin_amdgcn_mov_dpp(__float_as_uint(x), 0xB1, 0xF, 0xF, true)); }
__device__ __forceinline__ float dpp_xadd2(float x) { return x + __uint_as_float(__builtin_amdgcn_mov_dpp(__float_as_uint(x), 0x4E, 0xF, 0xF, true)); }
__device__ __forceinline__ float dpp_hmadd(float x) { return x + __uint_as_float(__builtin_amdgcn_mov_dpp(__float_as_uint(x), 0x141, 0xF, 0xF, true)); }
__device__ __forceinline__ float dpp_rmadd(float x) { return x + __uint_as_float(__builtin_amdgcn_mov_dpp(__float_as_uint(x), 0x140, 0xF, 0xF, true)); }

template <int ACT> struct EpiB {
    static constexpr bool PERM = true, AFTER_DRAIN = false;
    bf16_t* O; int ldc;
    __device__ __forceinline__ void operator()(const f32x4 (&acc)[2][2][4][2], const Unit& u, int wr, int wc, int fr, int fq) const {
        const int row0 = u.pm * BM + wr * 64 + fr, col0 = u.pn * BM + wc * 32 + 8 * fq;
#pragma unroll
        for (int ai = 0; ai < 2; ++ai)
#pragma unroll
            for (int m = 0; m < 4; ++m) { bf16_t* rowp = O + (size_t)(row0 + ai * HALF + m * 16) * ldc + col0;
#pragma unroll
                for (int bj = 0; bj < 2; ++bj) { f32x4 v0 = acc[ai][bj][m][0], v1 = acc[ai][bj][m][1];
                    if (ACT == 2) { v0 = __builtin_elementwise_max(v0, (f32x4){0.f, 0.f, 0.f, 0.f}); v1 = __builtin_elementwise_max(v1, (f32x4){0.f, 0.f, 0.f, 0.f}); v0 = v0 * v0; v1 = v1 * v1; }
                    u32x4 w; w.x = pk2(v0[0], v0[1]); w.y = pk2(v0[2], v0[3]); w.z = pk2(v1[0], v1[1]); w.w = pk2(v1[2], v1[3]);
                    *(u32x4*)(rowp + bj * HALF) = w; } }
    }
};
template <bool M3_ = false> struct EpiF32 {
    static constexpr bool PERM = false, AFTER_DRAIN = false, M3 = M3_;
    float* O; int ldc;
    __device__ __forceinline__ void operator()(const f32x4 (&acc)[2][2][4][2], const Unit& u, int wr, int wc, int fr, int fq) const {
        const int row0 = M3 ? u.pm * 192 + wr * 48 + fr : u.pm * BM + wr * 64 + fr, col0 = u.pn * BM + wc * 32 + 4 * fq;
#pragma unroll
        for (int ai = 0; ai < 2; ++ai)
#pragma unroll
            for (int m = 0; m < (M3 ? 3 : 4); ++m) { float* rowp = O + (size_t)(row0 + ai * (M3 ? 96 : HALF) + m * 16) * ldc + col0;
#pragma unroll
                for (int bj = 0; bj < 2; ++bj)
#pragma unroll
                    for (int n = 0; n < 2; ++n) *(f32x4*)(rowp + bj * HALF + n * 16) = acc[ai][bj][m][n]; }
    }
};
template <bool XG, bool M3_ = false> struct EpiRes {
    static constexpr bool PERM = false, AFTER_DRAIN = false, M3 = M3_;
    const float* base0; const float* base1; float* out; const float* gate;
    bf16_t* H; const float* normw; const float* scv; float* rowp;
    template <bool PERGROUP> __device__ __forceinline__ void rows(const f32x4 (&acc)[2][2][4][2], const Unit& u, int wr, int wc, int fr, int fq) const {
        constexpr int MG = M3 ? 3 : 4, NG = 2 * MG, AS = M3 ? 96 : HALF;
        const int row0 = M3 ? u.pm * 192 + wr * 48 + fr : u.pm * BM + wr * 64 + fr, col0 = u.pn * BM + wc * 32 + 4 * fq;
        f32x4 gv[2][2], gx[2][2], nw[2][2];
        if (XG) {
#pragma unroll
            for (int bj = 0; bj < 2; ++bj)
#pragma unroll
                for (int n = 0; n < 2; ++n) nw[bj][n] = *(const f32x4*)(normw + col0 + bj * HALF + n * 16); }
        if (!PERGROUP) { const size_t mo = (size_t)((M3 ? u.pm * 192 : u.pm * BM) >> 12) * 6144 + col0;
#pragma unroll
            for (int bj = 0; bj < 2; ++bj)
#pragma unroll
                for (int n = 0; n < 2; ++n) { gv[bj][n] = *(const f32x4*)(gate + mo + bj * HALF + n * 16);
                    if (XG) gx[bj][n] = nw[bj][n] * (*(const f32x4*)(scv + mo + bj * HALF + n * 16) + 1.f); } }
        f32x4 bq[2][4];
        { const int row = row0; const float* bb = (row < 4096) ? base0 : base1 - (size_t)4096 * 1024;
#pragma unroll
          for (int e = 0; e < 4; ++e) bq[0][e] = *(const f32x4*)(bb + (size_t)row * 1024 + col0 + (e >> 1) * HALF + (e & 1) * 16); }
#pragma unroll
        for (int gi = 0; gi < NG; ++gi) { const int ai = gi / MG, m = gi % MG; const int row = row0 + ai * AS + m * 16; const size_t off = (size_t)row * 1024 + col0; float ss = 0.f;
            if (gi + 1 < NG) { const int rn = row0 + ((gi + 1) / MG) * AS + ((gi + 1) % MG) * 16; const float* bn = (rn < 4096) ? base0 : base1 - (size_t)4096 * 1024;
#pragma unroll
                for (int e = 0; e < 4; ++e) bq[(gi + 1) & 1][e] = *(const f32x4*)(bn + (size_t)rn * 1024 + col0 + (e >> 1) * HALF + (e & 1) * 16); }
            if (PERGROUP) { const size_t mo = (size_t)(row >> 12) * 6144 + col0;
#pragma unroll
                for (int bj = 0; bj < 2; ++bj)
#pragma unroll
                    for (int n = 0; n < 2; ++n) { gv[bj][n] = *(const f32x4*)(gate + mo + bj * HALF + n * 16);
                        if (XG) gx[bj][n] = nw[bj][n] * (*(const f32x4*)(scv + mo + bj * HALF + n * 16) + 1.f); } }
#pragma unroll
            for (int bj = 0; bj < 2; ++bj)
#pragma unroll
                for (int n = 0; n < 2; ++n) { const f32x4 b = bq[gi & 1][bj * 2 + n];
                    const f32x4 o = b + gv[bj][n] * acc[ai][bj][m][n];
                    *(f32x4*)(out + off + bj * HALF + n * 16) = o;
                    if (XG) { const f32x4 xg = o * gx[bj][n]; u32x2v w; w.x = pk2(xg[0], xg[1]); w.y = pk2(xg[2], xg[3]); *(u32x2v*)(H + off + bj * HALF + n * 16) = w;
                        ss += (o[0] * o[0] + o[1] * o[1]) + (o[2] * o[2] + o[3] * o[3]); } }
            if (XG) { ss = xadd32(xadd16(ss)); if (fq == 0) rowp[(size_t)row * 16 + u.pn * 4 + wc] = ss; } }
    }
    __device__ __forceinline__ void operator()(const f32x4 (&acc)[2][2][4][2], const Unit& u, int wr, int wc, int fr, int fq) const {
        const bool straddle = M3 && (((u.pm * 192) >> 12) != ((u.pm * 192 + 191) >> 12));
        if (straddle) rows<true>(acc, u, wr, wc, fr, fq); else rows<false>(acc, u, wr, wc, fr, fq);
    }
};
__device__ __forceinline__ float row_rstd(const float* rowp, int row) {
    const f32x4* p = (const f32x4*)(rowp + (size_t)row * 16); const f32x4 a = p[0], b = p[1], c = p[2], d = p[3];
    const float s = ((a[0] + a[1]) + (a[2] + a[3])) + ((b[0] + b[1]) + (b[2] + b[3])) + ((c[0] + c[1]) + (c[2] + c[3])) + ((d[0] + d[1]) + (d[2] + d[3]));
    return __builtin_amdgcn_rsqf(s * (1.f / 1024.f) + 1e-6f);
}
__device__ __forceinline__ float rstd_from_quarter(const f32x4 q) {
    float s = (q[0] + q[1]) + (q[2] + q[3]); s = xadd32(xadd16(s));
    return __builtin_amdgcn_rsqf(s * (1.f / 1024.f) + 1e-6f);
}
struct EpiMlp1 {
    static constexpr bool PERM = true, AFTER_DRAIN = false;
    bf16_t* O; int ldc; const float* rowp; const float* shw;
    __device__ __forceinline__ void operator()(const f32x4 (&acc)[2][2][4][2], const Unit& u, int wr, int wc, int fr, int fq) const {
        const int row0 = u.pm * BM + wr * 64 + fr, col0 = u.pn * BM + wc * 32 + 8 * fq;
        const float* sw = shw + (size_t)(u.pm >> 4) * ldc + col0;
        f32x4 sv[2][2];
#pragma unroll
        for (int bj = 0; bj < 2; ++bj)
#pragma unroll
            for (int n = 0; n < 2; ++n) sv[bj][n] = *(const f32x4*)(sw + bj * HALF + 4 * n);
        f32x4 rq[2][4];
#pragma unroll
        for (int ai = 0; ai < 2; ++ai)
#pragma unroll
            for (int m = 0; m < 4; ++m) rq[ai][m] = *(const f32x4*)(rowp + (size_t)(row0 + ai * HALF + m * 16) * 16 + 4 * fq);
#pragma unroll
        for (int ai = 0; ai < 2; ++ai)
#pragma unroll
            for (int m = 0; m < 4; ++m) { const int row = row0 + ai * HALF + m * 16; const float rstd = rstd_from_quarter(rq[ai][m]); bf16_t* rowq = O + (size_t)row * ldc + col0;
#pragma unroll
                for (int bj = 0; bj < 2; ++bj) { f32x4 v0 = acc[ai][bj][m][0] * rstd + sv[bj][0], v1 = acc[ai][bj][m][1] * rstd + sv[bj][1];
                    v0 = __builtin_elementwise_max(v0, (f32x4){0.f, 0.f, 0.f, 0.f}); v1 = __builtin_elementwise_max(v1, (f32x4){0.f, 0.f, 0.f, 0.f}); v0 = v0 * v0; v1 = v1 * v1;
                    u32x4 w; w.x = pk2(v0[0], v0[1]); w.y = pk2(v0[2], v0[3]); w.z = pk2(v1[0], v1[1]); w.w = pk2(v1[2], v1[3]);
                    *(u32x4*)(rowq + bj * HALF) = w; } }
    }
};
template <bool M3_ = false> struct EpiQKV {
    static constexpr bool PERM = true, AFTER_DRAIN = false, M3 = M3_;
    bf16_t* Q1; float* outK; const float* qn; float qscale; const float* rowp; const float* shw;
    __device__ __forceinline__ void operator()(const f32x4 (&acc)[2][2][4][2], const Unit& u, int wr, int wc, int fr, int fq) const {
        const int sect = u.pn >> 2, head = (u.pn & 3) * 4 + wc;
        const int row0 = M3 ? u.pm * 192 + wr * 48 + fr : u.pm * BM + wr * 64 + fr, dcol = head * 64 + 8 * fq;
        bf16_t* dst = Q1 + (size_t)sect * 12582912;
        float* fo = outK + (size_t)(sect == 2 ? 4194304 : 0);
        const float* nw = qn + (sect == 0 ? 0 : 64);
        f32x4 wv[2][2];
#pragma unroll
        for (int bj = 0; bj < 2; ++bj)
#pragma unroll
            for (int n = 0; n < 2; ++n) wv[bj][n] = *(const f32x4*)(nw + 32 * bj + 8 * fq + 4 * n);
        const float sc = sect == 0 ? qscale : 1.f;
        f32x4 shv[2][2];
        const int scol = u.pn * BM + 32 * wc + 8 * fq;
        const bool straddle = M3 && (((u.pm * 192) >> 12) != ((u.pm * 192 + 191) >> 12));
        if (!straddle) { const size_t mo = (size_t)((M3 ? u.pm * 192 : u.pm * BM) >> 12) * 3072;
#pragma unroll
            for (int bj = 0; bj < 2; ++bj)
#pragma unroll
                for (int n = 0; n < 2; ++n) shv[bj][n] = *(const f32x4*)(shw + mo + scol + 128 * bj + 4 * n); }
        f32x4 rq[2][4];
#pragma unroll
        for (int ai = 0; ai < 2; ++ai)
#pragma unroll
            for (int m = 0; m < (M3 ? 3 : 4); ++m) rq[ai][m] = *(const f32x4*)(rowp + (size_t)(row0 + ai * (M3 ? 96 : HALF) + m * 16) * 16 + 4 * fq);
#pragma unroll
        for (int ai = 0; ai < 2; ++ai)
#pragma unroll
            for (int m = 0; m < (M3 ? 3 : 4); ++m) {
                const int row = row0 + ai * (M3 ? 96 : HALF) + m * 16;
                const float rstd_in = rstd_from_quarter(rq[ai][m]);
                if (straddle) {
#pragma unroll
                    for (int bj = 0; bj < 2; ++bj)
#pragma unroll
                        for (int n = 0; n < 2; ++n) shv[bj][n] = *(const f32x4*)(shw + (size_t)(row >> 12) * 3072 + scol + 128 * bj + 4 * n); }
                f32x4 v[2][2];
#pragma unroll
                for (int bj = 0; bj < 2; ++bj)
#pragma unroll
                    for (int n = 0; n < 2; ++n) v[bj][n] = acc[ai][bj][m][n] * rstd_in + shv[bj][n];
                if (sect < 2) {
                    float ss = 0.f;
#pragma unroll
                    for (int bj = 0; bj < 2; ++bj)
#pragma unroll
                        for (int n = 0; n < 2; ++n) { const f32x4 x = v[bj][n]; ss += (x[0] * x[0] + x[1] * x[1]) + (x[2] * x[2] + x[3] * x[3]); }
                    ss = xadd32(xadd16(ss));
                    const float rstd = __builtin_amdgcn_rsqf(ss * (1.f / 64.f) + 1e-6f) * sc;
#pragma unroll
                    for (int bj = 0; bj < 2; ++bj)
#pragma unroll
                        for (int n = 0; n < 2; ++n) v[bj][n] = v[bj][n] * rstd * wv[bj][n];
                }
#pragma unroll
                for (int bj = 0; bj < 2; ++bj) {
                    u32x4 w; w.x = pk2(v[bj][0][0], v[bj][0][1]); w.y = pk2(v[bj][0][2], v[bj][0][3]); w.z = pk2(v[bj][1][0], v[bj][1][1]); w.w = pk2(v[bj][1][2], v[bj][1][3]);
                    *(u32x4*)(dst + (size_t)row * 1024 + dcol + 32 * bj) = w;
                    if (sect >= 1 && row < 4096) { float* fp = fo + (size_t)row * 1024 + dcol + 32 * bj; *(f32x4*)fp = v[bj][0]; *(f32x4*)(fp + 4) = v[bj][1]; }
                }
            }
    }
};

template <class Epi, class Sched, bool ALIGN_EPI = false, bool SP2 = false, bool M3 = false>
__device__ __forceinline__ void gemm_phase(PG8_LAS unsigned char* lds, const Gemm g, const Sched& S, const Epi& E) {
    int tid_ = threadIdx.x; asm volatile("" : "+v"(tid_));
    const int tid = tid_, wid = __builtin_amdgcn_readfirstlane(tid >> 6), lane = tid & 63, wr = wid >> 2, wc = wid & 3, fr = lane & 15, fq = lane >> 4;
    int K_ = g.K; asm volatile("" : "+s"(K_));
    const int K = K_, nt = K / BK;
    unsigned voffA[2], voffB[2];
#pragma unroll
    for (int i = 0; i < 2; ++i) { int R, C; stage_rc(tid * 16 + i * 8192, R, C); const int Rb = Epi::PERM ? ((R & ~31) + perm32(R & 31)) : R;
        const int Ra = M3 ? ((R >> 6) * 48 + (((R >> 4) & 3) > 2 ? 2 : ((R >> 4) & 3)) * 16 + (R & 15)) : R;
        voffA[i] = (unsigned)(Ra * K + C) * 2u; voffB[i] = (unsigned)(Rb * K + C) * 2u; }
    const size_t kstep = (size_t)(BK * 2);
    const size_t hstep = (size_t)HALF * K * 2;
    const size_t tstep = 2 * hstep;
    const size_t hstepA = M3 ? (size_t)96 * K * 2 : hstep, tstepA = 2 * hstepA;
    const unsigned ldsw = (unsigned)wid * 1024u;
    const int aoff = lds_byte(wr * 64 + fr, fq * 8), boff = lds_byte(wc * 32 + fr, fq * 8);
#define PG8_SA(b, h) (((b) * 2 + (h)) * HTB)
#define PG8_SB(b, h) ((4 + (b) * 2 + (h)) * HTB)
#define PG8_STAGE(bufoff, gbase, voff) do { _Pragma("unroll") for (int _i = 0; _i < 2; ++_i) \
        __builtin_amdgcn_global_load_lds((const unsigned*)((const char*)(gbase) + (voff)[_i]), (PG8_LAS unsigned*)(lds + (bufoff) + ldsw + _i * 8192), 16, 0, 0); } while (0)
#define PG8_LDA(dst, b, h) do { _Pragma("unroll") for (int m = 0; m < (M3 ? 3 : 4); ++m) _Pragma("unroll") for (int k = 0; k < 2; ++k) dst[m][k] = *(const PG8_LAS bf16x8*)(lds + PG8_SA(b, h) + aoff + m * 2048 + k * 1024); } while (0)
#define PG8_LDB(dst, b, h) do { _Pragma("unroll") for (int n = 0; n < 2; ++n) _Pragma("unroll") for (int k = 0; k < 2; ++k) dst[n][k] = *(const PG8_LAS bf16x8*)(lds + PG8_SB(b, h) + boff + n * 2048 + k * 1024); } while (0)
#define PG8_MMA(ai, bj, At, Bt) do { __builtin_amdgcn_s_setprio(1); _Pragma("unroll") for (int m = 0; m < (M3 ? 3 : 4); ++m) _Pragma("unroll") for (int n = 0; n < 2; ++n) _Pragma("unroll") for (int k = 0; k < 2; ++k) \
        acc[ai][bj][m][n] = __builtin_amdgcn_mfma_f32_16x16x32_bf16(Bt[n][k], At[m][k], acc[ai][bj][m][n], 0, 0, 0); __builtin_amdgcn_s_setprio(0); } while (0)
#define PG8_WAIT_V(n) asm volatile("s_waitcnt vmcnt(" #n ")" ::: "memory")
#define PG8_WAIT_L(n) asm volatile("s_waitcnt lgkmcnt(" #n ")" ::: "memory")
#define PG8_BAR __builtin_amdgcn_s_barrier()
#define PG8_SCHED __builtin_amdgcn_sched_barrier(0)
    Unit cur, nxt; int ui = 0;
    if (!S.next(0, cur)) return;
    f32x4 acc[2][2][4][2];
#pragma unroll
    for (int a = 0; a < 2; ++a)
#pragma unroll
        for (int b = 0; b < 2; ++b)
#pragma unroll
            for (int m = 0; m < 4; ++m)
#pragma unroll
                for (int n = 0; n < 2; ++n) acc[a][b][m][n] = (f32x4){0.f, 0.f, 0.f, 0.f};
    bf16x8 At[4][2], B0[2][2], B1[2][2];
    const char* cA = (const char*)g.A + (size_t)cur.pm * tstepA; const char* cB = (const char*)g.Bt + (size_t)cur.pn * tstep;
    S.a_ready(cur);
    if constexpr (SP2) {
        PG8_STAGE(PG8_SB(0, 0), cB, voffB); PG8_STAGE(PG8_SB(0, 1), cB + hstep, voffB); PG8_STAGE(PG8_SA(0, 0), cA, voffA); PG8_STAGE(PG8_SA(0, 1), cA + hstepA, voffA);
        if (wr == 1) PG8_BAR;
        PG8_WAIT_V(2); PG8_BAR;
        PG8_STAGE(PG8_SB(1, 0), cB + kstep, voffB); PG8_STAGE(PG8_SA(1, 0), cA + kstep, voffA); PG8_STAGE(PG8_SB(1, 1), cB + hstep + kstep, voffB);
        PG8_WAIT_V(6); PG8_BAR;
    } else {
        PG8_STAGE(PG8_SB(0, 0), cB, voffB); PG8_STAGE(PG8_SA(0, 0), cA, voffA); PG8_STAGE(PG8_SB(0, 1), cB + hstep, voffB); PG8_STAGE(PG8_SA(0, 1), cA + hstepA, voffA);
        if (wr == 1) PG8_BAR;
        PG8_WAIT_V(4); PG8_BAR;
        PG8_STAGE(PG8_SB(1, 0), cB + kstep, voffB); PG8_STAGE(PG8_SA(1, 0), cA + kstep, voffA); PG8_STAGE(PG8_SB(1, 1), cB + hstep + kstep, voffB);
        PG8_WAIT_V(6); PG8_BAR;
    }
    for (;;) {
        const bool has_next = S.next(ui + 1, nxt);
        const char* nA = has_next ? (const char*)g.A + (size_t)nxt.pm * tstepA : cA; const char* nB = has_next ? (const char*)g.Bt + (size_t)nxt.pn * tstep : cB;
        for (int t = 0; t < nt; t += 2) {
            const bool last = (t == nt - 2);
            const char* a1 = cA + (size_t)(t + 1) * kstep;
            const char* a2 = last ? nA : cA + (size_t)(t + 2) * kstep; const char* b2 = last ? nB : cB + (size_t)(t + 2) * kstep;
            const char* a3 = a2 + kstep; const char* b3 = b2 + kstep;
            if (last && has_next) S.a_ready(nxt);
            if constexpr (SP2) {
            PG8_LDB(B0, 0, 0); PG8_LDB(B1, 0, 1); PG8_SCHED; PG8_LDA(At, 0, 0); PG8_STAGE(PG8_SA(1, 1), a1 + hstepA, voffA);
            PG8_WAIT_V(8); PG8_WAIT_L(0); PG8_BAR; PG8_MMA(0, 0, At, B0); PG8_MMA(0, 1, At, B1); PG8_BAR; PG8_SCHED;
            PG8_LDA(At, 0, 1); PG8_STAGE(PG8_SB(0, 0), b2, voffB); PG8_STAGE(PG8_SB(0, 1), b2 + hstep, voffB); PG8_STAGE(PG8_SA(0, 0), a2, voffA);
            PG8_WAIT_V(8); PG8_WAIT_L(0); PG8_BAR; PG8_MMA(1, 0, At, B0); PG8_MMA(1, 1, At, B1); PG8_BAR; PG8_SCHED;
            PG8_LDB(B0, 1, 0); PG8_LDB(B1, 1, 1); PG8_SCHED; PG8_LDA(At, 1, 0); PG8_STAGE(PG8_SA(0, 1), a2 + hstepA, voffA);
            PG8_WAIT_V(8); PG8_WAIT_L(0); PG8_BAR; PG8_MMA(0, 0, At, B0); PG8_MMA(0, 1, At, B1); PG8_BAR; PG8_SCHED;
            PG8_LDA(At, 1, 1); PG8_STAGE(PG8_SB(1, 0), b3, voffB); PG8_STAGE(PG8_SB(1, 1), b3 + hstep, voffB); PG8_STAGE(PG8_SA(1, 0), a3, voffA);
            PG8_WAIT_V(8); PG8_WAIT_L(0); PG8_BAR; PG8_MMA(1, 0, At, B0); PG8_MMA(1, 1, At, B1); PG8_BAR; PG8_SCHED;
            } else {
            PG8_LDB(B0, 0, 0); PG8_SCHED; PG8_LDA(At, 0, 0); PG8_STAGE(PG8_SA(1, 1), a1 + hstepA, voffA);
            PG8_WAIT_L(8); PG8_BAR; PG8_WAIT_L(0); PG8_MMA(0, 0, At, B0); PG8_BAR; PG8_SCHED;
            PG8_LDB(B1, 0, 1); PG8_STAGE(PG8_SB(0, 0), b2, voffB);
            PG8_BAR; PG8_WAIT_L(0); PG8_MMA(0, 1, At, B1); PG8_BAR;
            PG8_LDA(At, 0, 1); PG8_STAGE(PG8_SA(0, 0), a2, voffA);
            PG8_BAR; PG8_WAIT_L(0); PG8_MMA(1, 0, At, B0); PG8_BAR; PG8_SCHED;
            PG8_STAGE(PG8_SB(0, 1), b2 + hstep, voffB);
            PG8_WAIT_V(6); PG8_BAR; PG8_MMA(1, 1, At, B1); PG8_BAR;
            PG8_LDB(B0, 1, 0); PG8_SCHED; PG8_LDA(At, 1, 0); PG8_STAGE(PG8_SA(0, 1), a2 + hstepA, voffA);
            PG8_WAIT_L(8); PG8_BAR; PG8_WAIT_L(0); PG8_MMA(0, 0, At, B0); PG8_BAR; PG8_SCHED;
            PG8_LDB(B1, 1, 1); PG8_STAGE(PG8_SB(1, 0), b3, voffB);
            PG8_BAR; PG8_WAIT_L(0); PG8_MMA(0, 1, At, B1); PG8_BAR;
            PG8_LDA(At, 1, 1); PG8_STAGE(PG8_SA(1, 0), a3, voffA);
            PG8_BAR; PG8_WAIT_L(0); PG8_MMA(1, 0, At, B0); PG8_BAR; PG8_SCHED;
            PG8_STAGE(PG8_SB(1, 1), b3 + hstep, voffB);
            PG8_WAIT_V(6); PG8_BAR; PG8_MMA(1, 1, At, B1); PG8_BAR;
            }
        }
        if constexpr (ALIGN_EPI) { if (wr == 0) PG8_BAR; }
        if constexpr (!Epi::AFTER_DRAIN) { E(acc, cur, wr, wc, fr, fq); S.done(cur); }
        if (!has_next) break;
#pragma unroll
        for (int a = 0; a < 2; ++a)
#pragma unroll
            for (int b = 0; b < 2; ++b)
#pragma unroll
                for (int m = 0; m < 4; ++m)
#pragma unroll
                    for (int n = 0; n < 2; ++n) acc[a][b][m][n] = (f32x4){0.f, 0.f, 0.f, 0.f};
        cur = nxt; cA = nA; cB = nB; ++ui;
        if constexpr (ALIGN_EPI) { if (wr == 1) PG8_BAR; }
    }
    PG8_WAIT_V(0);
    if constexpr (!ALIGN_EPI) { if (wr == 0) PG8_BAR; }
    PG8_BAR;
    if constexpr (Epi::AFTER_DRAIN) { E.fused(acc, cur, wr, wc, fr, fq, lds, wid, lane); S.done(cur); }
#undef PG8_SA
#undef PG8_SB
#undef PG8_STAGE
#undef PG8_LDA
#undef PG8_LDB
#undef PG8_MMA
#undef PG8_WAIT_V
#undef PG8_WAIT_L
#undef PG8_BAR
#undef PG8_SCHED
}
}

#define LAS __attribute__((address_space(3)))
#define DI __device__ __forceinline__
typedef unsigned short bf16_t;
typedef short bf16x8 __attribute__((ext_vector_type(8)));
typedef short s16x4 __attribute__((ext_vector_type(4)));
typedef float f32x4 __attribute__((ext_vector_type(4)));
typedef float f32x2 __attribute__((ext_vector_type(2)));
typedef float f32x16 __attribute__((ext_vector_type(16)));
typedef unsigned u32x4 __attribute__((ext_vector_type(4)));
typedef unsigned u32x2 __attribute__((ext_vector_type(2)));
using pg8::pk2;

constexpr int NWAVES = 8, NTHREADS = 512;
constexpr int DM = 1024, FF = 4096, NPR = 4096, NTOK = 12288, NROWC = 13312;
constexpr float EPS = 1e-6f, LOG2E = 1.4426950408889634f;
constexpr int LDS_BYTES = 147456;
constexpr size_t MiB = 1u << 20;
constexpr size_t WS_MOD = 1 * MiB;
constexpr size_t WS_WIN0 = 2 * MiB, WS_WQUP = 4 * MiB, WS_WKVUP = 4 * MiB + 512 * 1024, WS_WPOOL = 5 * MiB, WS_WOUT0 = 6 * MiB;
constexpr size_t WS_W1_0 = 8 * MiB, WS_W2_0 = 16 * MiB, WS_W1_1 = 24 * MiB, WS_W2_1 = 32 * MiB, WS_WIN1 = 40 * MiB, WS_WOUT1 = 46 * MiB;
constexpr size_t WS_H = 48 * MiB, WS_CAT = 72 * MiB, WS_Y0 = 96 * MiB, WS_QRAW = 96 * MiB, WS_KVRAW = 114 * MiB;
constexpr size_t WS_POOLED = 144 * MiB, WS_QN = 156 * MiB, WS_CKVB = 162 * MiB, WS_KROPE = 166 * MiB, WS_QF = 168 * MiB, WS_KF = 186 * MiB, WS_VF = 206 * MiB;
constexpr size_t WS_CK1 = 220 * MiB, WS_CV1 = 222 * MiB, WS_U = 96 * MiB;
constexpr size_t WS_ROWP = 224 * MiB, WS_SHW1 = 225 * MiB, WS_SHWIN = 225 * MiB + 128 * 1024;
constexpr size_t WS_Q1 = 96 * MiB, WS_K1 = 120 * MiB, WS_V1 = 144 * MiB;
constexpr size_t OUT_CKV = 12582912, OUT_KROPE = 13107200, OUT_NAK = 13238272, OUT_NAV = 17432576;

struct Args {
    const float* in[35];
    float* out; unsigned char* ws;
    int ph_lo, ph_hi;
};

struct Ctx {
    LAS unsigned char* lds;
    int tid, lane, wave, G;
};

typedef const __attribute__((address_space(4))) Args* ArgsP;
DI ArgsP get_args() { ArgsP p = (ArgsP)__builtin_amdgcn_kernarg_segment_ptr(); asm volatile("" : "+s"(p)); return p; }

DI float wave_sum(float v) {
    v = pg8::dpp_rmadd(pg8::dpp_hmadd(pg8::dpp_xadd2(pg8::dpp_xadd1(v)))); v = pg8::xadd32(pg8::xadd16(v));
    return v;
}
#define LDS_WAIT() asm volatile("s_waitcnt lgkmcnt(0)" ::: "memory")

#define XB_TMO      128
#define XB_XCNT(j)  (256  + 64 * (j))
#define XB_XSUB(j)  (1280 + 64 * (j))
#define XB_XGEN(j)  (2304 + 64 * (j))
#define XB_TOP      3328
#define XB_TOPGEN   3392
#define XCD_BAR_WORDS 3456
#define XB_SPIN_CAP (1u << 18)

__device__ __forceinline__ unsigned xb_ld(unsigned* p)              { return __hip_atomic_load(p, __ATOMIC_RELAXED, __HIP_MEMORY_SCOPE_AGENT); }
__device__ __forceinline__ unsigned xb_add(unsigned* p, unsigned v) { return __hip_atomic_fetch_add(p, v, __ATOMIC_RELAXED, __HIP_MEMORY_SCOPE_AGENT); }
__device__ __forceinline__ unsigned xb_xcc_id() { return (unsigned)__builtin_amdgcn_s_getreg((3 << 11) | 20) & 0xFu; }
#define XB_SPIN(cond, bar) do { unsigned _sp = 0; while (cond) { __builtin_amdgcn_s_sleep(1); \
    if ((++_sp & 255u) == 0u) { if (xb_ld(&(bar)[XB_TMO])) break; if (_sp > XB_SPIN_CAP) { atomicAdd(&(bar)[XB_TMO], 1u); break; } } } } while (0)

struct XcdBarrier {
    unsigned* bar; unsigned x;
    volatile LAS unsigned* st;
};

__device__ __forceinline__ XcdBarrier xcd_barrier_post(unsigned* bar, volatile LAS unsigned* st) {
    XcdBarrier b; b.bar = bar; b.x = xb_xcc_id(); b.st = st;
    if (threadIdx.x == 0) (void)xb_add(&bar[XB_XCNT(b.x)], 1u);
    return b;
}
__device__ __forceinline__ void xcd_barrier_complete(unsigned* bar, unsigned x, unsigned& nloc, unsigned& nx) {
    const unsigned G = gridDim.x * gridDim.y * gridDim.z;
    unsigned sum, cnt, mine, sp = 0u;
    for (;;) {
        sum = 0u; cnt = 0u; mine = 0u;
#pragma unroll
        for (unsigned j = 0; j < 16; ++j) { const unsigned c = xb_ld(&bar[XB_XCNT(j)]); sum += c; cnt += (c > 0u) ? 1u : 0u; mine = (j == x) ? c : mine; }
        if (sum == G) break;
        __builtin_amdgcn_s_sleep(1);
        if ((++sp & 255u) == 0u) { if (xb_ld(&bar[XB_TMO])) break; if (sp > XB_SPIN_CAP) { atomicAdd(&bar[XB_TMO], 1u); break; } }
    }
    nloc = mine > 0u ? mine : 1u; nx = cnt > 0u ? cnt : 1u;
}

__device__ __forceinline__ void xcd_barrier(const XcdBarrier& b) {
    asm volatile("s_waitcnt vmcnt(0)" ::: "memory");
    __syncthreads();
    if (threadIdx.x == 0) {
        unsigned* bar = b.bar;
        __builtin_amdgcn_s_waitcnt(0);
        unsigned nloc = b.st[0], nx = b.st[1];
        if (nloc == 0u) { xcd_barrier_complete(bar, b.x, nloc, nx); b.st[0] = nloc; b.st[1] = nx; }
        const unsigned old = xb_add(&bar[XB_XSUB(b.x)], 1u);
        const unsigned gen = old / nloc;
        if (old + 1u == (gen + 1u) * nloc) {
            __builtin_amdgcn_fence(__ATOMIC_RELEASE, "agent");
            asm volatile("s_waitcnt vmcnt(0)" ::: "memory");
            const unsigned og = xb_add(&bar[XB_TOP], 1u);
            const unsigned tg = og / nx;
            if (og + 1u == (tg + 1u) * nx) xb_add(&bar[XB_TOPGEN], 1u);
            else XB_SPIN(xb_ld(&bar[XB_TOPGEN]) == tg, bar);
            __builtin_amdgcn_fence(__ATOMIC_ACQUIRE, "agent");
            xb_add(&bar[XB_XGEN(b.x)], 1u);
            asm volatile("s_waitcnt vmcnt(0)" ::: "memory");
        } else {
            XB_SPIN(xb_ld(&bar[XB_XGEN(b.x)]) == gen, bar);
            __builtin_amdgcn_fence(__ATOMIC_ACQUIRE, "agent");
            asm volatile("s_waitcnt vmcnt(0)" ::: "memory");
        }
    }
    __syncthreads();
}

DI void tr_item(const float* W, int ldw, int k0, int n0, bf16_t* WT, int ldt, int drow0, int dcol0, LAS float* scr, int lane, const float* rscale = nullptr) {
    { f32x4 v[8];
      const float* wp = W + (size_t)(k0 + (lane >> 3)) * ldw + n0 + 4 * (lane & 7);
#pragma unroll
      for (int i = 0; i < 8; ++i) v[i] = *(const f32x4*)(wp + (size_t)(8 * i) * ldw);
#pragma unroll
      for (int i = 0; i < 8; ++i) { LAS float* sp = scr + ((lane >> 3) + 8 * i) * 33 + 4 * (lane & 7); sp[0] = v[i][0]; sp[1] = v[i][1]; sp[2] = v[i][2]; sp[3] = v[i][3]; } }
    LDS_WAIT();
    const int c = lane & 7;
#pragma unroll
    for (int j = 0; j < 4; ++j) { const int n = (lane >> 3) + 8 * j; const LAS float* s = scr + (8 * c) * 33 + n;
        const float rs = rscale ? rscale[n] : 1.f;
        u32x4 o; o.x = pk2(s[0 * 33] * rs, s[1 * 33] * rs); o.y = pk2(s[2 * 33] * rs, s[3 * 33] * rs); o.z = pk2(s[4 * 33] * rs, s[5 * 33] * rs); o.w = pk2(s[6 * 33] * rs, s[7 * 33] * rs);
        *(u32x4*)(WT + (size_t)(drow0 + n) * ldt + dcol0 + 8 * c) = o; }
    LDS_WAIT();
}
template <bool PERMQKV> DI void tr_matrix_item(const float* W, int K, int N, bf16_t* WT, int item, LAS float* scr, int lane) {
    const int nblk = N / 32, kb = item / nblk, nb = item % nblk, n0 = nb * 32;
    int drow0 = n0;
    if (PERMQKV) { const int tile = n0 >> 8, loc = n0 & 255, wc = loc >> 6, bj = (loc >> 5) & 1; drow0 = tile * 256 + 128 * bj + 32 * wc; }
    tr_item(W, N, kb * 64, n0, WT, K, drow0, kb * 64, scr, lane);
}

DI void gemv3_core(const Ctx& C, const float* W, int N, int c0, LAS float* ldsf) {
    const int tid = C.tid, lane = C.lane, wave = C.wave, kq = tid >> 4, cl = tid & 15;
    f32x4 a0 = {0.f, 0.f, 0.f, 0.f}, a1 = a0, a2 = a0;
    const float* wp = W + (size_t)kq * N + c0 + 4 * cl;
#pragma unroll 8
    for (int i = 0; i < 32; ++i) { const f32x4 w = *(const f32x4*)(wp + (size_t)(32 * i) * N); const int k = kq + 32 * i;
        a0 += w * ldsf[k]; a1 += w * ldsf[1024 + k]; a2 += w * ldsf[2048 + k]; }
#pragma unroll
    for (int e = 0; e < 4; ++e) { a0[e] = pg8::xadd32(pg8::xadd16(a0[e])); a1[e] = pg8::xadd32(pg8::xadd16(a1[e])); a2[e] = pg8::xadd32(pg8::xadd16(a2[e])); }
    LAS float* part = ldsf + 3072 + 192;
    if (lane < 16) { *(LAS f32x4*)(part + (wave * 3 + 0) * 64 + 4 * cl) = a0; *(LAS f32x4*)(part + (wave * 3 + 1) * 64 + 4 * cl) = a1; *(LAS f32x4*)(part + (wave * 3 + 2) * 64 + 4 * cl) = a2; }
    __syncthreads();
    if (tid < 192) { float s = 0.f;
#pragma unroll
        for (int w = 0; w < 8; ++w) s += part[w * 192 + tid];
        ldsf[3072 + tid] = s; }
    __syncthreads();
}

DI void phase_prologue(const Ctx& C, ArgsP A) {
    LAS float* ldsf = (LAS float*)C.lds;
    const int tid = C.tid, lane = C.lane, wave = C.wave;
    float* MOD = (float*)(A->ws + WS_MOD);
    if (P0_PARTS & 1)
    for (int u = blockIdx.x; u < 192; u += C.G) {
        const int layer = u / 96, c0 = (u % 96) * 64;
        const float* W = layer ? A->in[24] : A->in[8]; const float* bias = layer ? A->in[25] : A->in[9];
        __syncthreads();
        for (int i = tid; i < 3072; i += NTHREADS) { const int m = i >> 10, k = i & 1023; const float v = (m == 0) ? A->in[7][k] : A->in[6][(m - 1) * 1024 + k]; ldsf[i] = v / (1.f + expf(-v)); }
        __syncthreads();
        gemv3_core(C, W, 6144, c0, ldsf);
        if (tid < 192) { const int m = tid >> 6, l = tid & 63;
            MOD[(size_t)(layer * 3 + m) * 6144 + c0 + l] = ldsf[3072 + tid] + bias[c0 + l]; }
    }
    __syncthreads();
    {
        LAS float* scr = (LAS float*)(C.lds + wave * 16384);
        const int gw = blockIdx.x * NWAVES + wave, NGW = C.G * NWAVES;
        bf16_t* WIN0 = (bf16_t*)(A->ws + WS_WIN0); bf16_t* WQUP = (bf16_t*)(A->ws + WS_WQUP); bf16_t* WKVUP = (bf16_t*)(A->ws + WS_WKVUP); bf16_t* WPOOL = (bf16_t*)(A->ws + WS_WPOOL);
        bf16_t* WOUT0 = (bf16_t*)(A->ws + WS_WOUT0); bf16_t* W1_0 = (bf16_t*)(A->ws + WS_W1_0); bf16_t* W2_0 = (bf16_t*)(A->ws + WS_W2_0); bf16_t* W1_1 = (bf16_t*)(A->ws + WS_W1_1);
        bf16_t* W2_1 = (bf16_t*)(A->ws + WS_W2_1); bf16_t* WIN1 = (bf16_t*)(A->ws + WS_WIN1); bf16_t* WOUT1 = (bf16_t*)(A->ws + WS_WOUT1);
        constexpr int I_IN0 = 16 * 29, I_QUP = 4 * 24, I_KVUP = 2 * 32, I_POOL = 32, I_OUT = 16 * 32;
        constexpr int NITEMS = I_IN0 + I_QUP + I_KVUP + I_POOL + I_OUT;
        if (P0_PARTS & 2)
        for (int it = gw; it < NITEMS; it += NGW) {
            int r = it;
            if (r < I_IN0) { const int kb = r / 29, nb = r % 29; tr_item(A->in[14], 928, kb * 64, nb * 32, WIN0, 1024, nb * 32, kb * 64, scr, lane); continue; } r -= I_IN0;
            if (r < I_QUP) { tr_matrix_item<false>(A->in[17], 256, 768, WQUP, r, scr, lane); continue; } r -= I_QUP;
            if (r < I_KVUP) { tr_matrix_item<false>(A->in[18], 128, 1024, WKVUP, r, scr, lane); continue; } r -= I_KVUP;
            if (r < I_POOL) { const int g = r >> 3, kb = (r >> 2) & 1, nb = r & 3; tr_item(A->in[21] + (size_t)g * 128 * 128, 128, kb * 64, nb * 32, WPOOL, 512, g * 128 + nb * 32, g * 128 + kb * 64, scr, lane, A->in[22] + g * 128 + nb * 32); continue; }
            r -= I_POOL;
            tr_matrix_item<false>(A->in[23], 1024, 1024, WOUT0, r, scr, lane);
        }
        const int gt = blockIdx.x * NTHREADS + tid, NGT = C.G * NTHREADS;
        const u32x4 z = {0u, 0u, 0u, 0u};
        if (P0_PARTS & 4) {
        for (int c = gt; c < 96 * 128; c += NGT) *(u32x4*)(WIN0 + (size_t)928 * 1024 + (size_t)c * 8) = z;
        for (int c = gt; c < 512 * 64; c += NGT) { const int row = c >> 6, col0 = (c & 63) * 8; if ((row >> 7) != (col0 >> 7)) *(u32x4*)(WPOOL + (size_t)row * 512 + col0) = z; }
        if (gt < 128) ((float*)(A->ws + WS_MOD + 256 * 1024))[gt] = gt < 64 ? A->in[31][gt] : A->in[32][gt - 64];
        bf16_t* CKVB = (bf16_t*)(A->ws + WS_CKVB); float* KROPE = (float*)(A->ws + WS_KROPE); bf16_t* CK1 = (bf16_t*)(A->ws + WS_CK1); bf16_t* CV1 = (bf16_t*)(A->ws + WS_CV1);
        for (int c = gt; c < 1024 * 128 / 4; c += NGT) { const f32x4 v = *(const f32x4*)(A->in[2] + (size_t)c * 4); u32x2 o; o.x = pk2(v[0], v[1]); o.y = pk2(v[2], v[3]); *(u32x2*)(CKVB + (size_t)NTOK * 128 + (size_t)c * 4) = o; }
        for (int c = gt; c < 1024 * 32 / 4; c += NGT) *(f32x4*)(KROPE + (size_t)NTOK * 32 + (size_t)c * 4) = *(const f32x4*)(A->in[3] + (size_t)c * 4);
        for (int c = gt; c < 1024 * 1024 / 4; c += NGT) {
            const f32x4 v = *(const f32x4*)(A->in[4] + (size_t)c * 4); u32x2 o; o.x = pk2(v[0], v[1]); o.y = pk2(v[2], v[3]); *(u32x2*)(CK1 + (size_t)c * 4) = o;
            const f32x4 w = *(const f32x4*)(A->in[5] + (size_t)c * 4); u32x2 p; p.x = pk2(w[0], w[1]); p.y = pk2(w[2], w[3]); *(u32x2*)(CV1 + (size_t)c * 4) = p; }
        }
    }
}

template <int SET> DI void deferred_transposes(const Ctx& C, ArgsP A, int first) {
    const int nb = C.G - first, me = (int)blockIdx.x - first;
    if (me < 0) return;
    LAS float* scr = (LAS float*)(C.lds + C.wave * 16384);
    const int gw = me * NWAVES + C.wave, NGW = nb * NWAVES, lane = C.lane;
    constexpr int I_M1 = 16 * 128, I_M2 = 64 * 32, I_IN1 = 16 * 96, I_OUT = 16 * 32;
    if (SET == 0) { bf16_t* W1_0 = (bf16_t*)(A->ws + WS_W1_0); for (int it = gw; it < I_M1; it += NGW) tr_matrix_item<false>(A->in[12], 1024, 4096, W1_0, it, scr, lane); }
    if (SET == 1) { bf16_t* W2_0 = (bf16_t*)(A->ws + WS_W2_0); for (int it = gw; it < I_M2; it += NGW) tr_matrix_item<false>(A->in[13], 4096, 1024, W2_0, it, scr, lane); }
    if (SET == 2) {
        bf16_t* W1_1 = (bf16_t*)(A->ws + WS_W1_1); bf16_t* W2_1 = (bf16_t*)(A->ws + WS_W2_1); bf16_t* WIN1 = (bf16_t*)(A->ws + WS_WIN1); bf16_t* WOUT1 = (bf16_t*)(A->ws + WS_WOUT1);
        for (int it = gw; it < I_M1 + I_M2 + I_IN1 + I_OUT; it += NGW) {
            int r = it;
            if (r < I_M1) { tr_matrix_item<false>(A->in[28], 1024, 4096, W1_1, r, scr, lane); continue; } r -= I_M1;
            if (r < I_M2) { tr_matrix_item<false>(A->in[29], 4096, 1024, W2_1, r, scr, lane); continue; } r -= I_M2;
            if (r < I_IN1) { tr_matrix_item<true>(A->in[30], 1024, 3072, WIN1, r, scr, lane); continue; } r -= I_IN1;
            tr_matrix_item<false>(A->in[34], 1024, 1024, WOUT1, r, scr, lane);
        }
    }
}

template <bool PERMQKV> DI void gemv_sh_unit(const Ctx& C, const float* W, int N, const float* shvec  , float* outv  , int unit) {
    LAS float* ldsf = (LAS float*)C.lds;
    const int tid = C.tid, lane = C.lane, wave = C.wave, c0 = unit * 64;
    __syncthreads();
    for (int i = tid; i < 3072; i += NTHREADS) ldsf[i] = shvec[(size_t)(i >> 10) * 6144 + (i & 1023)];
    __syncthreads();
    gemv3_core(C, W, N, c0, ldsf);
    if (tid < 192) { const int m = tid >> 6, l = tid & 63;
        int dc = c0 + l;
        if (PERMQKV) { const int tile = dc >> 8, loc = dc & 255; dc = tile * 256 + 128 * ((loc >> 5) & 1) + 32 * (loc >> 6) + (loc & 31); }
        outv[(size_t)m * N + dc] = ldsf[3072 + tid]; }
}

DI void phase_modulate(const Ctx& C, ArgsP A, const float* x0, const float* x1, const float* normw, const float* mod, int sh_off, int sc_off) {
    bf16_t* H = (bf16_t*)(A->ws + WS_H);
    const int gw = blockIdx.x * NWAVES + C.wave, NGW = C.G * NWAVES, lane = C.lane;
    for (int r = gw; r < NTOK; r += 2 * NGW) {
        const int rb = r + NGW; const bool two = rb < NTOK; const int r2 = two ? rb : r;
        const float* xa = (r < NPR) ? x0 + (size_t)r * DM : x1 + (size_t)(r - NPR) * DM;
        const float* xb = (r2 < NPR) ? x0 + (size_t)r2 * DM : x1 + (size_t)(r2 - NPR) * DM;
        f32x4 va[4], vb[4]; float sa = 0.f, sb = 0.f;
#pragma unroll
        for (int j = 0; j < 4; ++j) { va[j] = *(const f32x4*)(xa + 4 * (lane + 64 * j)); vb[j] = *(const f32x4*)(xb + 4 * (lane + 64 * j)); }
#pragma unroll
        for (int j = 0; j < 4; ++j) { sa += (va[j][0] * va[j][0] + va[j][1] * va[j][1]) + (va[j][2] * va[j][2] + va[j][3] * va[j][3]); sb += (vb[j][0] * vb[j][0] + vb[j][1] * vb[j][1]) + (vb[j][2] * vb[j][2] + vb[j][3] * vb[j][3]); }
        const float rsa = __builtin_amdgcn_rsqf(wave_sum(sa) * (1.f / DM) + EPS), rsb = __builtin_amdgcn_rsqf(wave_sum(sb) * (1.f / DM) + EPS);
        const float* ma = mod + (size_t)(r >> 12) * 6144; const float* mb = mod + (size_t)(r2 >> 12) * 6144;
#pragma unroll
        for (int j = 0; j < 4; ++j) { const int col = 4 * (lane + 64 * j);
            const f32x4 w = *(const f32x4*)(normw + col);
            { const f32x4 sc = *(const f32x4*)(ma + sc_off + col), sh = *(const f32x4*)(ma + sh_off + col); const f32x4 h = (va[j] * rsa * w) * (sc + 1.f) + sh;
              u32x2 o; o.x = pk2(h[0], h[1]); o.y = pk2(h[2], h[3]); *(u32x2*)(H + (size_t)r * DM + col) = o; }
            if (two) { const f32x4 sc = *(const f32x4*)(mb + sc_off + col), sh = *(const f32x4*)(mb + sh_off + col); const f32x4 h = (vb[j] * rsb * w) * (sc + 1.f) + sh;
              u32x2 o; o.x = pk2(h[0], h[1]); o.y = pk2(h[2], h[3]); *(u32x2*)(H + (size_t)r2 * DM + col) = o; } }
    }
}

DI void phase_post_in0(const Ctx& C, ArgsP A) {
    const float* Y0 = (const float*)(A->ws + WS_Y0);
    bf16_t* POOLED = (bf16_t*)(A->ws + WS_POOLED); bf16_t* QN = (bf16_t*)(A->ws + WS_QN); bf16_t* CKVB = (bf16_t*)(A->ws + WS_CKVB); float* KROPE = (float*)(A->ws + WS_KROPE);
    const float* qln = A->in[15]; const float* kvln = A->in[16];
    const int gw = blockIdx.x * NWAVES + C.wave, NGW = C.G * NWAVES, lane = C.lane;
    const f32x4 qw = *(const f32x4*)(qln + 4 * lane); const f32x2 kw = *(const f32x2*)(kvln + 2 * lane);
    for (int r = gw; r < NTOK; r += NGW) {
        const float* Y = Y0 + (size_t)r * 1024;
        int S, t; if (r < NPR) { S = 256; t = r & 255; } else { S = 4096; t = (r - NPR) & 4095; }
        const float* Yseq = Y0 + (size_t)(r - t) * 1024;
        const f32x4 q = *(const f32x4*)(Y + 512 + 4 * lane);
        const f32x2 k = *(const f32x2*)(Y + 768 + 2 * lane);
        const float kr = Y[896 + (lane & 31)];
        f32x2 ps[4], pa[4]; float pinv[4];
#pragma unroll
        for (int g = 0; g < 4; ++g) {
            const int win = 2 << g; int lo = t - win / 2, hi = lo + win; lo = lo < 0 ? 0 : lo; hi = hi > S ? S : hi;
            const int col = g * 128 + 2 * lane;
            f32x2 s2 = {0.f, 0.f};
#pragma unroll
            for (int kk = 0; kk < win; ++kk) { const int j = t - win / 2 + kk; const int jc = j < 0 ? 0 : (j >= S ? S - 1 : j);
                const f32x2 v = *(const f32x2*)(Yseq + (size_t)jc * 1024 + col); const float wgt = (j >= 0 && j < S) ? 1.f : 0.f; s2 += v * wgt; }
            ps[g] = s2; pa[g] = *(const f32x2*)(Y + col); pinv[g] = 1.f / (float)(hi - lo);
        }
        const float ssq = wave_sum((q[0] * q[0] + q[1] * q[1]) + (q[2] * q[2] + q[3] * q[3]));
        const float ssk = wave_sum(k[0] * k[0] + k[1] * k[1]);
#pragma unroll
        for (int g = 0; g < 4; ++g) *(unsigned*)(POOLED + (size_t)r * 512 + g * 128 + 2 * lane) = pk2(ps[g][0] * pinv[g] - pa[g][0], ps[g][1] * pinv[g] - pa[g][1]);
        { const float rstd = __builtin_amdgcn_rsqf(ssq * (1.f / 256.f) + EPS); const f32x4 o = q * rstd * qw;
          u32x2 p; p.x = pk2(o[0], o[1]); p.y = pk2(o[2], o[3]); *(u32x2*)(QN + (size_t)r * 256 + 4 * lane) = p; }
        { const float rstd = __builtin_amdgcn_rsqf(ssk * (1.f / 128.f) + EPS); const f32x2 o = k * rstd * kw;
          *(unsigned*)(CKVB + (size_t)r * 128 + 2 * lane) = pk2(o[0], o[1]);
          if (r < NPR) *(f32x2*)(A->out + OUT_CKV + (size_t)r * 128 + 2 * lane) = o; }
        if (lane < 32) { KROPE[(size_t)r * 32 + lane] = kr; if (r < NPR) A->out[OUT_KROPE + (size_t)r * 32 + lane] = kr; }
    }
}

DI float bf2f(bf16_t b) { return __uint_as_float((unsigned)b << 16); }
DI bf16_t f2bf1(float v) { return (bf16_t)(pk2(v, 0.f) & 0xffffu); }
DI void phase_mla_finish(const Ctx& C, ArgsP A) {
    const bf16_t* QRAW = (const bf16_t*)(A->ws + WS_QRAW); const bf16_t* KVRAW = (const bf16_t*)(A->ws + WS_KVRAW); const float* KROPE = (const float*)(A->ws + WS_KROPE);
    bf16_t* QF = (bf16_t*)(A->ws + WS_QF); bf16_t* KF = (bf16_t*)(A->ws + WS_KF); bf16_t* VF = (bf16_t*)(A->ws + WS_VF);
    const float* qnw = A->in[19]; const float* knw = A->in[20];
    const int tid = C.tid, lane = C.lane, wave = C.wave;
    LAS float* tab = (LAS float*)(C.lds + 65536);
    LAS float* qs = (LAS float*)(C.lds + wave * 8192);
    __syncthreads();
    for (int i = tid; i < 512; i += NTHREADS) { const int pos = i >> 3, f = i & 7; const float ang = (float)pos * exp2f(-(float)f * (13.287712379549449f / 8.f)); tab[2 * i] = cosf(ang); tab[2 * i + 1] = sinf(ang); }
    __syncthreads();
    const float QSC = 0.10206207261596577f * LOG2E;
    const int gw = blockIdx.x * NWAVES + wave, NGW = C.G * NWAVES;
    const int hh = lane >> 3, d0 = 12 * (lane & 7);
    for (int r = gw; r < NROWC; r += NGW) {
        const bool is_tok = r < NTOK, latent = (r >= NPR) && is_tok;
        const int t = (r - NPR) & 4095, prow = t >> 6, pcol = t & 63;
        size_t dst;
        if (r < NPR) dst = r; else if (is_tok) dst = (size_t)NPR + (size_t)((r - NPR) >> 12) * 4608 + t; else { const int i = r - NTOK; dst = (size_t)NPR + (size_t)(i >> 9) * 4608 + 4096 + (i & 511); }
        const int l8 = lane & 7;
        const u32x4 kn = *(const u32x4*)(KVRAW + (size_t)r * 1024 + hh * 128 + 8 * l8); const f32x4 krp = *(const f32x4*)(KROPE + (size_t)r * 32 + 4 * l8);
        const u32x4 vv = *(const u32x4*)(KVRAW + (size_t)r * 1024 + hh * 128 + 64 + 8 * l8);
        if (is_tok) {
            float x[12]; float ss = 0.f;
            const s16x4* qp = (const s16x4*)(QRAW + (size_t)r * 768 + 12 * lane);
#pragma unroll
            for (int c = 0; c < 3; ++c) { const s16x4 v = qp[c];
#pragma unroll
                for (int e = 0; e < 4; ++e) { x[4 * c + e] = bf2f((bf16_t)v[e]); ss += x[4 * c + e] * x[4 * c + e]; } }
            ss = pg8::dpp_hmadd(pg8::dpp_xadd2(pg8::dpp_xadd1(ss)));
            const float rstd = __builtin_amdgcn_rsqf(ss * (1.f / 96.f) + EPS);
#pragma unroll
            for (int i = 0; i < 12; ++i) qs[12 * lane + i] = x[i] * rstd * qnw[d0 + i];
            LDS_WAIT();
#pragma unroll
            for (int i = 0; i < 12; ++i) { const int e = lane + 64 * i, d = e % 96; const float v0 = qs[e];
                const int j = (d - 64) & 31, jj = j & 15, f = jj & 7, pos = (j >> 4) ? pcol : prow; const bool lo = jj < 8; const int pe = lo ? e + 8 : (e >= 8 ? e - 8 : 0);
                const float pv = qs[pe], cs = tab[2 * (pos * 8 + f)], sn = tab[2 * (pos * 8 + f) + 1];
                const float rot = lo ? v0 * cs - pv * sn : pv * sn + v0 * cs; const float v = (latent && d >= 64) ? rot : v0;
                QF[(size_t)r * 768 + e] = f2bf1(v * QSC); }
            LDS_WAIT();
        }
        {
            float x[12]; float ss = 0.f; const f32x4 kr = krp;
#pragma unroll
            for (int c = 0; c < 4; ++c) { x[2 * c] = __uint_as_float(kn[c] << 16); x[2 * c + 1] = __uint_as_float(kn[c] & 0xffff0000u); x[8 + c] = kr[c]; }
#pragma unroll
            for (int i = 0; i < 12; ++i) ss += x[i] * x[i];
            ss = pg8::dpp_hmadd(pg8::dpp_xadd2(pg8::dpp_xadd1(ss)));
            const float rstd = __builtin_amdgcn_rsqf(ss * (1.f / 96.f) + EPS);
#pragma unroll
            for (int i = 0; i < 8; ++i) qs[hh * 96 + 8 * l8 + i] = x[i] * rstd * knw[8 * l8 + i];
#pragma unroll
            for (int i = 0; i < 4; ++i) qs[hh * 96 + 64 + 4 * l8 + i] = x[8 + i] * rstd * knw[64 + 4 * l8 + i];
            LDS_WAIT();
#pragma unroll
            for (int i = 0; i < 12; ++i) { const int e = lane + 64 * i, d = e % 96; const float v0 = qs[e];
                const int j = (d - 64) & 31, jj = j & 15, f = jj & 7, pos = (j >> 4) ? pcol : prow; const bool lo = jj < 8; const int pe = lo ? e + 8 : (e >= 8 ? e - 8 : 0);
                const float pv = qs[pe], cs = tab[2 * (pos * 8 + f)], sn = tab[2 * (pos * 8 + f) + 1];
                const float rot = lo ? v0 * cs - pv * sn : pv * sn + v0 * cs; const float v = (latent && d >= 64) ? rot : v0;
                KF[dst * 768 + e] = f2bf1(v); }
            LDS_WAIT();
        }
        *(u32x4*)(VF + dst * 512 + hh * 64 + 8 * l8) = vv;
    }
}

DI float max3f(float a, float b, float c) { float r; asm("v_max3_f32 %0, %1, %2, %3" : "=v"(r) : "v"(a), "v"(b), "v"(c)); return r; }
constexpr int ATT_K_OFF = 0, ATT_V_OFF = 13312, ATT_VRS = 192  , ATT_BUF = 13312 + 64 * ATT_VRS, ATT_B_OFF = 122880;
static_assert(2 * ATT_BUF <= 69632 && 69632 <= ATT_B_OFF, "attention LDS map");
DI void softmax_step(f32x16& s, float& m, float& l, f32x16& oa, f32x16& ob) {
    s = s - m;
    const float x0 = max3f(s[0], s[1], s[2]), x1 = max3f(s[3], s[4], s[5]), x2 = max3f(s[6], s[7], s[8]), x3 = max3f(s[9], s[10], s[11]), x4 = max3f(s[12], s[13], s[14]);
    float mxr = max3f(max3f(x0, x1, x2), max3f(x3, x4, s[15]), -1e30f);
    if (__builtin_amdgcn_ballot_w64(mxr > 8.f) != 0ull) {
        mxr = pg8::xmax32(mxr);
        const float delta = fmaxf(mxr, 0.f), alpha = __builtin_amdgcn_exp2f(-delta);
        m += delta; s = s - delta; l *= alpha; oa = oa * alpha; ob = ob * alpha;
    }
#pragma unroll
    for (int i = 0; i < 16; ++i) s[i] = __builtin_amdgcn_exp2f(s[i]);
    l += (((s[0] + s[1]) + (s[2] + s[3])) + ((s[4] + s[5]) + (s[6] + s[7]))) + (((s[8] + s[9]) + (s[10] + s[11])) + ((s[12] + s[13]) + (s[14] + s[15])));
}
DI bf16x8 pack8(const f32x16& s, int jj) {
    u32x4 pw; pw.x = pk2(s[8 * jj + 0], s[8 * jj + 1]); pw.y = pk2(s[8 * jj + 2], s[8 * jj + 3]); pw.z = pk2(s[8 * jj + 4], s[8 * jj + 5]); pw.w = pk2(s[8 * jj + 6], s[8 * jj + 7]);
    return __builtin_bit_cast(bf16x8, pw);
}
template <int DQ, int MODE, int qstride, int kstride, int vstride, int ostride>
DI void attn_unit(LAS unsigned char* lds, const bf16_t* Q,
                  const bf16_t* K0, const bf16_t* V0, int n0, const bf16_t* K1p, const bf16_t* V1p, int nT,
                  bf16_t* O, int kr_lo, int r0) {
    const int tid = threadIdx.x, lane = tid & 63, wave = tid >> 6, r32 = lane & 31, hi = lane >> 5, pg = wave >> 1, ksub = wave & 1;
    constexpr int KS = DQ + 8, NKC = DQ / 8, NS = DQ / 16;
    const LAS float* Bl = (const LAS float*)(lds + ATT_B_OFF);
    bf16x8 qf[2][NS];
#pragma unroll
    for (int qg = 0; qg < 2; ++qg) { const bf16_t* qp = Q + (size_t)(pg * 64 + qg * 32 + r32) * qstride + 8 * hi;
#pragma unroll
      for (int s = 0; s < NS; ++s) qf[qg][s] = *(const bf16x8*)(qp + 16 * s); }
    f32x16 o[2][2];
#pragma unroll
    for (int i = 0; i < 16; ++i) { o[0][0][i] = 0.f; o[0][1][i] = 0.f; o[1][0][i] = 0.f; o[1][1][i] = 0.f; }
    float m[2] = {0.f, 0.f}, l[2] = {0.f, 0.f};
    const int kc0 = tid, krow0 = kc0 / NKC, kcc0 = kc0 % NKC;
    const int kc1 = tid + 512, krow1 = kc1 / NKC, kcc1 = kc1 % NKC;
    const bool k2 = (DQ == 96) && (tid < 256);
    const int vkey = tid >> 3, vdc = tid & 7;
    u32x4 kA0, kA1 = {0u, 0u, 0u, 0u}, vA, kB0 = {0u, 0u, 0u, 0u}, kB1 = {0u, 0u, 0u, 0u}, vB = {0u, 0u, 0u, 0u};
    const int qr = r0 + pg, rs = qr - 4 < 0 ? 0 : (qr - 4 > 56 ? 56 : qr - 4);
    const unsigned vtr_off = (unsigned)((32 * ksub + 4 * hi + ((lane & 15) >> 2)) * ATT_VRS + (16 * ((lane >> 4) & 1) + 4 * (lane & 3)) * 2);
#define ATT_WRITE(b, K0_, K1_, V_) do { LAS bf16_t* Kw = (LAS bf16_t*)(lds + (b) * ATT_BUF + ATT_K_OFF); LAS unsigned char* Vw = lds + (b) * ATT_BUF + ATT_V_OFF; \
        *(LAS u32x4*)(Kw + krow0 * KS + kcc0 * 8) = K0_; if (k2) *(LAS u32x4*)(Kw + krow1 * KS + kcc1 * 8) = K1_; \
        *(LAS u32x4*)(Vw + vkey * ATT_VRS + vdc * 16) = V_; } while (0)
#define ATT_LOAD(tn_, K0_, K1_, V_) do { const int tn = (tn_); const bf16_t* kt = (tn < n0) ? K0 + (size_t)tn * 64 * kstride : K1p + (size_t)(tn - n0) * 64 * kstride; const bf16_t* vt = (tn < n0) ? V0 + (size_t)tn * 64 * vstride : V1p + (size_t)(tn - n0) * 64 * vstride; \
        K0_ = *(const u32x4*)(kt + (size_t)krow0 * kstride + kcc0 * 8); if (k2) K1_ = *(const u32x4*)(kt + (size_t)krow1 * kstride + kcc1 * 8); \
        V_ = *(const u32x4*)(vt + (size_t)vkey * vstride + vdc * 8); } while (0)
    if constexpr (DQ == 96) {
    ATT_LOAD(0, kA0, kA1, vA);
    __syncthreads();
    ATT_WRITE(0, kA0, kA1, vA);
    if (nT > 1) ATT_LOAD(1, kA0, kA1, vA);
    __syncthreads();
    for (int t = 0; t < nT; ++t) {
        const LAS bf16_t* Kl = (const LAS bf16_t*)(lds + (t & 1) * ATT_BUF + ATT_K_OFF);
        bool local = false, skip = false; int krow = 0;
        if (MODE == 1) { local = t < n0; krow = kr_lo + t; skip = local && (krow < rs || krow >= rs + 8); }
        if (!skip) {
        f32x16 sc[2];
#pragma unroll
        for (int i = 0; i < 16; ++i) { sc[0][i] = 0.f; sc[1][i] = 0.f; }
        bf16x8 kf[NS];
#pragma unroll
        for (int st = 0; st < NS; ++st) kf[st] = *(const LAS bf16x8*)(Kl + (32 * ksub + r32) * KS + 16 * st + 8 * hi);
        __builtin_amdgcn_sched_barrier(0);
        __builtin_amdgcn_s_setprio(1);
#pragma unroll
        for (int st = 0; st < NS; ++st) sc[0] = __builtin_amdgcn_mfma_f32_32x32x16_bf16(kf[st], qf[0][st], sc[0], 0, 0, 0);
#pragma unroll
        for (int st = 0; st < NS; ++st) sc[1] = __builtin_amdgcn_mfma_f32_32x32x16_bf16(kf[st], qf[1][st], sc[1], 0, 0, 0);
        __builtin_amdgcn_s_setprio(0);
        __builtin_amdgcn_sched_barrier(0);
        u32x2 vt0, vt1, vt2, vt3, vt4, vt5, vt6, vt7;
        { const unsigned va = (unsigned)(size_t)(lds + (t & 1) * ATT_BUF + ATT_V_OFF) + vtr_off;
          asm volatile("ds_read_b64_tr_b16 %0, %8\n\tds_read_b64_tr_b16 %1, %8 offset:1536\n\tds_read_b64_tr_b16 %2, %8 offset:3072\n\tds_read_b64_tr_b16 %3, %8 offset:4608\n\t"
                       "ds_read_b64_tr_b16 %4, %8 offset:64\n\tds_read_b64_tr_b16 %5, %8 offset:1600\n\tds_read_b64_tr_b16 %6, %8 offset:3136\n\tds_read_b64_tr_b16 %7, %8 offset:4672"
                       : "=&v"(vt0), "=&v"(vt1), "=&v"(vt2), "=&v"(vt3), "=&v"(vt4), "=&v"(vt5), "=&v"(vt6), "=&v"(vt7) : "v"(va) : "memory"); }
        __builtin_amdgcn_sched_barrier(0);
#define NA_MASK(QG) do { if (MODE == 1) { if (local) { const LAS float* brow = Bl + (krow - qr + 7) * 32; \
            const int qc = 32 * (QG) + r32, cs0 = qc - 8 < 0 ? 0 : (qc - 8 > 48 ? 48 : qc - 8); \
            const int d0 = 32 * ksub + 4 * hi - cs0; const LAS float* bp = brow + (32 * ksub + 4 * hi - qc + 15); float bvv[16]; \
            _Pragma("unroll") for (int i = 0; i < 16; ++i) bvv[i] = bp[8 * (i >> 2) + (i & 3)]; \
            asm volatile("" : "+v"(bvv[0]), "+v"(bvv[1]), "+v"(bvv[2]), "+v"(bvv[3]), "+v"(bvv[4]), "+v"(bvv[5]), "+v"(bvv[6]), "+v"(bvv[7]), "+v"(bvv[8]), "+v"(bvv[9]), "+v"(bvv[10]), "+v"(bvv[11]), "+v"(bvv[12]), "+v"(bvv[13]), "+v"(bvv[14]), "+v"(bvv[15])); \
            _Pragma("unroll") for (int i = 0; i < 16; ++i) { const int c = 8 * (i >> 2) + (i & 3); sc[QG][i] = ((unsigned)(d0 + c) < 16u) ? sc[QG][i] + bvv[i] : -1e30f; } } } } while (0)
#define NA_SPARSE(QG, I0, PB) do { const LAS float* brow = Bl + (krow - qr + 7) * 32; \
            const int qc = 32 * (QG) + r32, cs0 = qc - 8 < 0 ? 0 : (qc - 8 > 48 ? 48 : qc - 8); \
            const int d0 = 32 * ksub + 4 * hi - cs0; const LAS float* bp = brow + (32 * ksub + 4 * hi - qc + 15); float e_[4]; \
            float b_[4]; _Pragma("unroll") for (int k_ = 0; k_ < 4; ++k_) { const int i_ = (I0) + k_; b_[k_] = bp[8 * (i_ >> 2) + (i_ & 3)]; } \
            asm volatile("" : "+v"(b_[0]), "+v"(b_[1]), "+v"(b_[2]), "+v"(b_[3])); \
            _Pragma("unroll") for (int k_ = 0; k_ < 4; ++k_) { const int i_ = (I0) + k_, c_ = 8 * (i_ >> 2) + (i_ & 3); e_[k_] = (((unsigned)(d0 + c_) < 16u) ? sc[QG][i_] + b_[k_] : -1e30f) - m[QG]; } \
            float mx_ = fmaxf(max3f(e_[0], e_[1], e_[2]), e_[3]); \
            if (__builtin_amdgcn_ballot_w64(mx_ > 8.f) != 0ull) { mx_ = pg8::xmax32(mx_); const float dl_ = fmaxf(mx_, 0.f), al_ = __builtin_amdgcn_exp2f(-dl_); \
                m[QG] += dl_; l[QG] *= al_; o[QG][0] = o[QG][0] * al_; o[QG][1] = o[QG][1] * al_; _Pragma("unroll") for (int k_ = 0; k_ < 4; ++k_) e_[k_] -= dl_; } \
            _Pragma("unroll") for (int k_ = 0; k_ < 4; ++k_) e_[k_] = __builtin_amdgcn_exp2f(e_[k_]); \
            l[QG] += (e_[0] + e_[1]) + (e_[2] + e_[3]); \
            u32x4 pw_ = {0u, 0u, 0u, 0u}; if ((I0) == 0) { pw_.x = pk2(e_[0], e_[1]); pw_.y = pk2(e_[2], e_[3]); } else { pw_.z = pk2(e_[0], e_[1]); pw_.w = pk2(e_[2], e_[3]); } \
            PB = __builtin_bit_cast(bf16x8, pw_); } while (0)
        bool sp0 = false, sp1 = false;
        if (MODE == 1) { sp0 = local && (ksub == 1); sp1 = local && (ksub == 0); }
        bf16x8 p00, p01;
        if (sp0) { NA_SPARSE(0, 0, p00); p01 = p00; }
        else { NA_MASK(0); softmax_step(sc[0], m[0], l[0], o[0][0], o[0][1]); p00 = pack8(sc[0], 0); p01 = pack8(sc[0], 1); }
        asm volatile("s_waitcnt lgkmcnt(0)" : "+v"(vt0), "+v"(vt1), "+v"(vt2), "+v"(vt3), "+v"(vt4), "+v"(vt5), "+v"(vt6), "+v"(vt7) :: "memory");
        const u32x4 a00 = {vt0.x, vt0.y, vt1.x, vt1.y}, a01 = {vt2.x, vt2.y, vt3.x, vt3.y}, a10 = {vt4.x, vt4.y, vt5.x, vt5.y}, a11 = {vt6.x, vt6.y, vt7.x, vt7.y};
        __builtin_amdgcn_s_setprio(1);
        o[0][0] = __builtin_amdgcn_mfma_f32_32x32x16_bf16(__builtin_bit_cast(bf16x8, a00), p00, o[0][0], 0, 0, 0);
        o[0][1] = __builtin_amdgcn_mfma_f32_32x32x16_bf16(__builtin_bit_cast(bf16x8, a10), p00, o[0][1], 0, 0, 0);
        if (!sp0) {
          o[0][0] = __builtin_amdgcn_mfma_f32_32x32x16_bf16(__builtin_bit_cast(bf16x8, a01), p01, o[0][0], 0, 0, 0);
          o[0][1] = __builtin_amdgcn_mfma_f32_32x32x16_bf16(__builtin_bit_cast(bf16x8, a11), p01, o[0][1], 0, 0, 0); }
        __builtin_amdgcn_s_setprio(0);
        __builtin_amdgcn_sched_barrier(0);
        bf16x8 p10, p11;
        if (sp1) { NA_SPARSE(1, 12, p11); p10 = p11; }
        else { NA_MASK(1); softmax_step(sc[1], m[1], l[1], o[1][0], o[1][1]); p10 = pack8(sc[1], 0); p11 = pack8(sc[1], 1); }
        __builtin_amdgcn_s_setprio(1);
        o[1][0] = __builtin_amdgcn_mfma_f32_32x32x16_bf16(__builtin_bit_cast(bf16x8, a01), p11, o[1][0], 0, 0, 0);
        o[1][1] = __builtin_amdgcn_mfma_f32_32x32x16_bf16(__builtin_bit_cast(bf16x8, a11), p11, o[1][1], 0, 0, 0);
        if (!sp1) {
          o[1][0] = __builtin_amdgcn_mfma_f32_32x32x16_bf16(__builtin_bit_cast(bf16x8, a00), p10, o[1][0], 0, 0, 0);
          o[1][1] = __builtin_amdgcn_mfma_f32_32x32x16_bf16(__builtin_bit_cast(bf16x8, a10), p10, o[1][1], 0, 0, 0); }
        __builtin_amdgcn_s_setprio(0);
#undef NA_SPARSE
#undef NA_MASK
        }
        if (t + 1 < nT) { ATT_WRITE((t + 1) & 1, kA0, kA1, vA); if (t + 2 < nT) ATT_LOAD(t + 2, kA0, kA1, vA); }
        __syncthreads();
    }
    } else {
    ATT_LOAD(0, kA0, kA1, vA);
    if (nT > 1) ATT_LOAD(1, kB0, kB1, vB);
    __syncthreads();
    ATT_WRITE(0, kA0, kA1, vA);
    if (nT > 2) ATT_LOAD(2, kA0, kA1, vA);
    __syncthreads();
    for (int t0 = 0; t0 < nT; t0 += 2) {
        { const int t = t0;
        const LAS bf16_t* Kl = (const LAS bf16_t*)(lds + (t & 1) * ATT_BUF + ATT_K_OFF);
        bool local = false, skip = false; int krow = 0;
        if (MODE == 1) { local = t < n0; krow = kr_lo + t; skip = local && (krow < rs || krow >= rs + 8); }
        if (!skip) {
        f32x16 sc[2];
#pragma unroll
        for (int i = 0; i < 16; ++i) { sc[0][i] = 0.f; sc[1][i] = 0.f; }
        bf16x8 kf[NS];
#pragma unroll
        for (int st = 0; st < NS; ++st) kf[st] = *(const LAS bf16x8*)(Kl + (32 * ksub + r32) * KS + 16 * st + 8 * hi);
        __builtin_amdgcn_sched_barrier(0);
        __builtin_amdgcn_s_setprio(1);
#pragma unroll
        for (int st = 0; st < NS; ++st) sc[0] = __builtin_amdgcn_mfma_f32_32x32x16_bf16(kf[st], qf[0][st], sc[0], 0, 0, 0);
#pragma unroll
        for (int st = 0; st < NS; ++st) sc[1] = __builtin_amdgcn_mfma_f32_32x32x16_bf16(kf[st], qf[1][st], sc[1], 0, 0, 0);
        __builtin_amdgcn_s_setprio(0);
        __builtin_amdgcn_sched_barrier(0);
        u32x2 vt0, vt1, vt2, vt3, vt4, vt5, vt6, vt7;
        { const unsigned va = (unsigned)(size_t)(lds + (t & 1) * ATT_BUF + ATT_V_OFF) + vtr_off;
          asm volatile("ds_read_b64_tr_b16 %0, %8\n\tds_read_b64_tr_b16 %1, %8 offset:1536\n\tds_read_b64_tr_b16 %2, %8 offset:3072\n\tds_read_b64_tr_b16 %3, %8 offset:4608\n\t"
                       "ds_read_b64_tr_b16 %4, %8 offset:64\n\tds_read_b64_tr_b16 %5, %8 offset:1600\n\tds_read_b64_tr_b16 %6, %8 offset:3136\n\tds_read_b64_tr_b16 %7, %8 offset:4672"
                       : "=&v"(vt0), "=&v"(vt1), "=&v"(vt2), "=&v"(vt3), "=&v"(vt4), "=&v"(vt5), "=&v"(vt6), "=&v"(vt7) : "v"(va) : "memory"); }
        __builtin_amdgcn_sched_barrier(0);
#define NA_MASK(QG) do { if (MODE == 1) { if (local) { const LAS float* brow = Bl + (krow - qr + 7) * 32; \
            const int qc = 32 * (QG) + r32, cs0 = qc - 8 < 0 ? 0 : (qc - 8 > 48 ? 48 : qc - 8); \
            const int d0 = 32 * ksub + 4 * hi - cs0; const LAS float* bp = brow + (32 * ksub + 4 * hi - qc + 15); float bvv[16]; \
            _Pragma("unroll") for (int i = 0; i < 16; ++i) bvv[i] = bp[8 * (i >> 2) + (i & 3)]; \
            asm volatile("" : "+v"(bvv[0]), "+v"(bvv[1]), "+v"(bvv[2]), "+v"(bvv[3]), "+v"(bvv[4]), "+v"(bvv[5]), "+v"(bvv[6]), "+v"(bvv[7]), "+v"(bvv[8]), "+v"(bvv[9]), "+v"(bvv[10]), "+v"(bvv[11]), "+v"(bvv[12]), "+v"(bvv[13]), "+v"(bvv[14]), "+v"(bvv[15])); \
            _Pragma("unroll") for (int i = 0; i < 16; ++i) { const int c = 8 * (i >> 2) + (i & 3); sc[QG][i] = ((unsigned)(d0 + c) < 16u) ? sc[QG][i] + bvv[i] : -1e30f; } } } } while (0)
#define NA_SPARSE(QG, I0, PB) do { const LAS float* brow = Bl + (krow - qr + 7) * 32; \
            const int qc = 32 * (QG) + r32, cs0 = qc - 8 < 0 ? 0 : (qc - 8 > 48 ? 48 : qc - 8); \
            const int d0 = 32 * ksub + 4 * hi - cs0; const LAS float* bp = brow + (32 * ksub + 4 * hi - qc + 15); float e_[4]; \
            float b_[4]; _Pragma("unroll") for (int k_ = 0; k_ < 4; ++k_) { const int i_ = (I0) + k_; b_[k_] = bp[8 * (i_ >> 2) + (i_ & 3)]; } \
            asm volatile("" : "+v"(b_[0]), "+v"(b_[1]), "+v"(b_[2]), "+v"(b_[3])); \
            _Pragma("unroll") for (int k_ = 0; k_ < 4; ++k_) { const int i_ = (I0) + k_, c_ = 8 * (i_ >> 2) + (i_ & 3); e_[k_] = (((unsigned)(d0 + c_) < 16u) ? sc[QG][i_] + b_[k_] : -1e30f) - m[QG]; } \
            float mx_ = fmaxf(max3f(e_[0], e_[1], e_[2]), e_[3]); \
            if (__builtin_amdgcn_ballot_w64(mx_ > 8.f) != 0ull) { mx_ = pg8::xmax32(mx_); const float dl_ = fmaxf(mx_, 0.f), al_ = __builtin_amdgcn_exp2f(-dl_); \
                m[QG] += dl_; l[QG] *= al_; o[QG][0] = o[QG][0] * al_; o[QG][1] = o[QG][1] * al_; _Pragma("unroll") for (int k_ = 0; k_ < 4; ++k_) e_[k_] -= dl_; } \
            _Pragma("unroll") for (int k_ = 0; k_ < 4; ++k_) e_[k_] = __builtin_amdgcn_exp2f(e_[k_]); \
            l[QG] += (e_[0] + e_[1]) + (e_[2] + e_[3]); \
            u32x4 pw_ = {0u, 0u, 0u, 0u}; if ((I0) == 0) { pw_.x = pk2(e_[0], e_[1]); pw_.y = pk2(e_[2], e_[3]); } else { pw_.z = pk2(e_[0], e_[1]); pw_.w = pk2(e_[2], e_[3]); } \
            PB = __builtin_bit_cast(bf16x8, pw_); } while (0)
        bool sp0 = false, sp1 = false;
        if (MODE == 1) { sp0 = local && (ksub == 1); sp1 = local && (ksub == 0); }
        bf16x8 p00, p01;
        if (sp0) { NA_SPARSE(0, 0, p00); p01 = p00; }
        else { NA_MASK(0); softmax_step(sc[0], m[0], l[0], o[0][0], o[0][1]); p00 = pack8(sc[0], 0); p01 = pack8(sc[0], 1); }
        asm volatile("s_waitcnt lgkmcnt(0)" : "+v"(vt0), "+v"(vt1), "+v"(vt2), "+v"(vt3), "+v"(vt4), "+v"(vt5), "+v"(vt6), "+v"(vt7) :: "memory");
        const u32x4 a00 = {vt0.x, vt0.y, vt1.x, vt1.y}, a01 = {vt2.x, vt2.y, vt3.x, vt3.y}, a10 = {vt4.x, vt4.y, vt5.x, vt5.y}, a11 = {vt6.x, vt6.y, vt7.x, vt7.y};
        __builtin_amdgcn_s_setprio(1);
        o[0][0] = __builtin_amdgcn_mfma_f32_32x32x16_bf16(__builtin_bit_cast(bf16x8, a00), p00, o[0][0], 0, 0, 0);
        o[0][1] = __builtin_amdgcn_mfma_f32_32x32x16_bf16(__builtin_bit_cast(bf16x8, a10), p00, o[0][1], 0, 0, 0);
        if (!sp0) {
          o[0][0] = __builtin_amdgcn_mfma_f32_32x32x16_bf16(__builtin_bit_cast(bf16x8, a01), p01, o[0][0], 0, 0, 0);
          o[0][1] = __builtin_amdgcn_mfma_f32_32x32x16_bf16(__builtin_bit_cast(bf16x8, a11), p01, o[0][1], 0, 0, 0); }
        __builtin_amdgcn_s_setprio(0);
        __builtin_amdgcn_sched_barrier(0);
        bf16x8 p10, p11;
        if (sp1) { NA_SPARSE(1, 12, p11); p10 = p11; }
        else { NA_MASK(1); softmax_step(sc[1], m[1], l[1], o[1][0], o[1][1]); p10 = pack8(sc[1], 0); p11 = pack8(sc[1], 1); }
        __builtin_amdgcn_s_setprio(1);
        o[1][0] = __builtin_amdgcn_mfma_f32_32x32x16_bf16(__builtin_bit_cast(bf16x8, a01), p11, o[1][0], 0, 0, 0);
        o[1][1] = __builtin_amdgcn_mfma_f32_32x32x16_bf16(__builtin_bit_cast(bf16x8, a11), p11, o[1][1], 0, 0, 0);
        if (!sp1) {
          o[1][0] = __builtin_amdgcn_mfma_f32_32x32x16_bf16(__builtin_bit_cast(bf16x8, a00), p10, o[1][0], 0, 0, 0);
          o[1][1] = __builtin_amdgcn_mfma_f32_32x32x16_bf16(__builtin_bit_cast(bf16x8, a10), p10, o[1][1], 0, 0, 0); }
        __builtin_amdgcn_s_setprio(0);
#undef NA_SPARSE
#undef NA_MASK
        }
        if (t + 1 < nT) { ATT_WRITE((t + 1) & 1, kB0, kB1, vB); if (t + 3 < nT) ATT_LOAD(t + 3, kB0, kB1, vB); }
        __syncthreads(); }
        if (t0 + 1 < nT) { const int t = t0 + 1;
        const LAS bf16_t* Kl = (const LAS bf16_t*)(lds + (t & 1) * ATT_BUF + ATT_K_OFF);
        bool local = false, skip = false; int krow = 0;
        if (MODE == 1) { local = t < n0; krow = kr_lo + t; skip = local && (krow < rs || krow >= rs + 8); }
        if (!skip) {
        f32x16 sc[2];
#pragma unroll
        for (int i = 0; i < 16; ++i) { sc[0][i] = 0.f; sc[1][i] = 0.f; }
        bf16x8 kf[NS];
#pragma unroll
        for (int st = 0; st < NS; ++st) kf[st] = *(const LAS bf16x8*)(Kl + (32 * ksub + r32) * KS + 16 * st + 8 * hi);
        __builtin_amdgcn_sched_barrier(0);
        __builtin_amdgcn_s_setprio(1);
#pragma unroll
        for (int st = 0; st < NS; ++st) sc[0] = __builtin_amdgcn_mfma_f32_32x32x16_bf16(kf[st], qf[0][st], sc[0], 0, 0, 0);
#pragma unroll
        for (int st = 0; st < NS; ++st) sc[1] = __builtin_amdgcn_mfma_f32_32x32x16_bf16(kf[st], qf[1][st], sc[1], 0, 0, 0);
        __builtin_amdgcn_s_setprio(0);
        __builtin_amdgcn_sched_barrier(0);
        u32x2 vt0, vt1, vt2, vt3, vt4, vt5, vt6, vt7;
        { const unsigned va = (unsigned)(size_t)(lds + (t & 1) * ATT_BUF + ATT_V_OFF) + vtr_off;
          asm volatile("ds_read_b64_tr_b16 %0, %8\n\tds_read_b64_tr_b16 %1, %8 offset:1536\n\tds_read_b64_tr_b16 %2, %8 offset:3072\n\tds_read_b64_tr_b16 %3, %8 offset:4608\n\t"
                       "ds_read_b64_tr_b16 %4, %8 offset:64\n\tds_read_b64_tr_b16 %5, %8 offset:1600\n\tds_read_b64_tr_b16 %6, %8 offset:3136\n\tds_read_b64_tr_b16 %7, %8 offset:4672"
                       : "=&v"(vt0), "=&v"(vt1), "=&v"(vt2), "=&v"(vt3), "=&v"(vt4), "=&v"(vt5), "=&v"(vt6), "=&v"(vt7) : "v"(va) : "memory"); }
        __builtin_amdgcn_sched_barrier(0);
#define NA_MASK(QG) do { if (MODE == 1) { if (local) { const LAS float* brow = Bl + (krow - qr + 7) * 32; \
            const int qc = 32 * (QG) + r32, cs0 = qc - 8 < 0 ? 0 : (qc - 8 > 48 ? 48 : qc - 8); \
            const int d0 = 32 * ksub + 4 * hi - cs0; const LAS float* bp = brow + (32 * ksub + 4 * hi - qc + 15); float bvv[16]; \
            _Pragma("unroll") for (int i = 0; i < 16; ++i) bvv[i] = bp[8 * (i >> 2) + (i & 3)]; \
            asm volatile("" : "+v"(bvv[0]), "+v"(bvv[1]), "+v"(bvv[2]), "+v"(bvv[3]), "+v"(bvv[4]), "+v"(bvv[5]), "+v"(bvv[6]), "+v"(bvv[7]), "+v"(bvv[8]), "+v"(bvv[9]), "+v"(bvv[10]), "+v"(bvv[11]), "+v"(bvv[12]), "+v"(bvv[13]), "+v"(bvv[14]), "+v"(bvv[15])); \
            _Pragma("unroll") for (int i = 0; i < 16; ++i) { const int c = 8 * (i >> 2) + (i & 3); sc[QG][i] = ((unsigned)(d0 + c) < 16u) ? sc[QG][i] + bvv[i] : -1e30f; } } } } while (0)
#define NA_SPARSE(QG, I0, PB) do { const LAS float* brow = Bl + (krow - qr + 7) * 32; \
            const int qc = 32 * (QG) + r32, cs0 = qc - 8 < 0 ? 0 : (qc - 8 > 48 ? 48 : qc - 8); \
            const int d0 = 32 * ksub + 4 * hi - cs0; const LAS float* bp = brow + (32 * ksub + 4 * hi - qc + 15); float e_[4]; \
            float b_[4]; _Pragma("unroll") for (int k_ = 0; k_ < 4; ++k_) { const int i_ = (I0) + k_; b_[k_] = bp[8 * (i_ >> 2) + (i_ & 3)]; } \
            asm volatile("" : "+v"(b_[0]), "+v"(b_[1]), "+v"(b_[2]), "+v"(b_[3])); \
            _Pragma("unroll") for (int k_ = 0; k_ < 4; ++k_) { const int i_ = (I0) + k_, c_ = 8 * (i_ >> 2) + (i_ & 3); e_[k_] = (((unsigned)(d0 + c_) < 16u) ? sc[QG][i_] + b_[k_] : -1e30f) - m[QG]; } \
            float mx_ = fmaxf(max3f(e_[0], e_[1], e_[2]), e_[3]); \
            if (__builtin_amdgcn_ballot_w64(mx_ > 8.f) != 0ull) { mx_ = pg8::xmax32(mx_); const float dl_ = fmaxf(mx_, 0.f), al_ = __builtin_amdgcn_exp2f(-dl_); \
                m[QG] += dl_; l[QG] *= al_; o[QG][0] = o[QG][0] * al_; o[QG][1] = o[QG][1] * al_; _Pragma("unroll") for (int k_ = 0; k_ < 4; ++k_) e_[k_] -= dl_; } \
            _Pragma("unroll") for (int k_ = 0; k_ < 4; ++k_) e_[k_] = __builtin_amdgcn_exp2f(e_[k_]); \
            l[QG] += (e_[0] + e_[1]) + (e_[2] + e_[3]); \
            u32x4 pw_ = {0u, 0u, 0u, 0u}; if ((I0) == 0) { pw_.x = pk2(e_[0], e_[1]); pw_.y = pk2(e_[2], e_[3]); } else { pw_.z = pk2(e_[0], e_[1]); pw_.w = pk2(e_[2], e_[3]); } \
            PB = __builtin_bit_cast(bf16x8, pw_); } while (0)
        bool sp0 = false, sp1 = false;
        if (MODE == 1) { sp0 = local && (ksub == 1); sp1 = local && (ksub == 0); }
        bf16x8 p00, p01;
        if (sp0) { NA_SPARSE(0, 0, p00); p01 = p00; }
        else { NA_MASK(0); softmax_step(sc[0], m[0], l[0], o[0][0], o[0][1]); p00 = pack8(sc[0], 0); p01 = pack8(sc[0], 1); }
        asm volatile("s_waitcnt lgkmcnt(0)" : "+v"(vt0), "+v"(vt1), "+v"(vt2), "+v"(vt3), "+v"(vt4), "+v"(vt5), "+v"(vt6), "+v"(vt7) :: "memory");
        const u32x4 a00 = {vt0.x, vt0.y, vt1.x, vt1.y}, a01 = {vt2.x, vt2.y, vt3.x, vt3.y}, a10 = {vt4.x, vt4.y, vt5.x, vt5.y}, a11 = {vt6.x, vt6.y, vt7.x, vt7.y};
        __builtin_amdgcn_s_setprio(1);
        o[0][0] = __builtin_amdgcn_mfma_f32_32x32x16_bf16(__builtin_bit_cast(bf16x8, a00), p00, o[0][0], 0, 0, 0);
        o[0][1] = __builtin_amdgcn_mfma_f32_32x32x16_bf16(__builtin_bit_cast(bf16x8, a10), p00, o[0][1], 0, 0, 0);
        if (!sp0) {
          o[0][0] = __builtin_amdgcn_mfma_f32_32x32x16_bf16(__builtin_bit_cast(bf16x8, a01), p01, o[0][0], 0, 0, 0);
          o[0][1] = __builtin_amdgcn_mfma_f32_32x32x16_bf16(__builtin_bit_cast(bf16x8, a11), p01, o[0][1], 0, 0, 0); }
        __builtin_amdgcn_s_setprio(0);
        __builtin_amdgcn_sched_barrier(0);
        bf16x8 p10, p11;
        if (sp1) { NA_SPARSE(1, 12, p11); p10 = p11; }
        else { NA_MASK(1); softmax_step(sc[1], m[1], l[1], o[1][0], o[1][1]); p10 = pack8(sc[1], 0); p11 = pack8(sc[1], 1); }
        __builtin_amdgcn_s_setprio(1);
        o[1][0] = __builtin_amdgcn_mfma_f32_32x32x16_bf16(__builtin_bit_cast(bf16x8, a01), p11, o[1][0], 0, 0, 0);
        o[1][1] = __builtin_amdgcn_mfma_f32_32x32x16_bf16(__builtin_bit_cast(bf16x8, a11), p11, o[1][1], 0, 0, 0);
        if (!sp1) {
          o[1][0] = __builtin_amdgcn_mfma_f32_32x32x16_bf16(__builtin_bit_cast(bf16x8, a00), p10, o[1][0], 0, 0, 0);
          o[1][1] = __builtin_amdgcn_mfma_f32_32x32x16_bf16(__builtin_bit_cast(bf16x8, a10), p10, o[1][1], 0, 0, 0); }
        __builtin_amdgcn_s_setprio(0);
#undef NA_SPARSE
#undef NA_MASK
        }
        if (t + 1 < nT) { ATT_WRITE((t + 1) & 1, kA0, kA1, vA); if (t + 3 < nT) ATT_LOAD(t + 3, kA0, kA1, vA); }
        __syncthreads(); }
    }
    }
#undef ATT_WRITE
#undef ATT_LOAD
    LAS float* mg = (LAS float*)lds + (size_t)pg * (68 * 64) + lane;
    if (ksub == 1) {
#pragma unroll
        for (int qg = 0; qg < 2; ++qg) { mg[(qg * 34 + 0) * 64] = m[qg]; mg[(qg * 34 + 1) * 64] = l[qg];
#pragma unroll
            for (int dt = 0; dt < 2; ++dt)
#pragma unroll
                for (int i = 0; i < 16; ++i) mg[(qg * 34 + 2 + dt * 16 + i) * 64] = o[qg][dt][i]; }
    }
    __syncthreads();
    if (ksub == 0) {
#pragma unroll
        for (int qg = 0; qg < 2; ++qg) {
            const float m1 = mg[(qg * 34 + 0) * 64], l1 = mg[(qg * 34 + 1) * 64];
            const float mt = fmaxf(m[qg], m1), a0 = __builtin_amdgcn_exp2f(m[qg] - mt), a1 = __builtin_amdgcn_exp2f(m1 - mt);
            float lt = l[qg] * a0 + l1 * a1; lt = pg8::xadd32(lt);
            const float inv = 1.f / lt, c0 = a0 * inv, c1 = a1 * inv;
            bf16_t* op = O + (size_t)(pg * 64 + qg * 32 + r32) * ostride + 4 * hi;
#pragma unroll
            for (int dt = 0; dt < 2; ++dt)
#pragma unroll
                for (int g = 0; g < 4; ++g) {
                    float v[4];
#pragma unroll
                    for (int e = 0; e < 4; ++e) v[e] = o[qg][dt][4 * g + e] * c0 + mg[(qg * 34 + 2 + dt * 16 + 4 * g + e) * 64] * c1;
                    u32x2 w; w.x = pk2(v[0], v[1]); w.y = pk2(v[2], v[3]); *(u32x2*)(op + 32 * dt + 8 * g) = w; }
        }
    }
}

DI void phase_mla_attn(const Ctx& C, ArgsP A) {
    const bf16_t* QF = (const bf16_t*)(A->ws + WS_QF); const bf16_t* KF = (const bf16_t*)(A->ws + WS_KF); const bf16_t* VF = (const bf16_t*)(A->ws + WS_VF);
    bf16_t* CAT = (bf16_t*)(A->ws + WS_CAT);
    const int bx = blockIdx.x;
    for (int u = bx; u < 256; u += C.G) {
        const int x = u & 7, j = u >> 3, bh = 2 * x + (j >> 4), b = bh >> 3, h = bh & 7, qb = j & 15;
        const size_t qrow = (size_t)NPR + (size_t)b * 4096 + (size_t)qb * 256, krow = (size_t)NPR + (size_t)b * 4608;
        attn_unit<96, 0, 768, 768, 512, 1024>(C.lds, QF + qrow * 768 + h * 96, KF + krow * 768 + h * 96, VF + krow * 512 + h * 64, 72, nullptr, nullptr, 72, CAT + qrow * 1024 + 512 + h * 64, 0, 0);
    }
    for (int u = bx; u < 128; u += C.G) {
        const int b = u >> 3, h = u & 7; const size_t row = (size_t)b * 256;
        attn_unit<96, 0, 768, 768, 512, 1024>(C.lds, QF + row * 768 + h * 96, KF + row * 768 + h * 96, VF + row * 512 + h * 64, 4, nullptr, nullptr, 4, CAT + row * 1024 + 512 + h * 64, 0, 0);
    }
}
DI void phase_na_attn(const Ctx& C, ArgsP A) {
    const bf16_t* Q1 = (const bf16_t*)(A->ws + WS_Q1); const bf16_t* K1 = (const bf16_t*)(A->ws + WS_K1); const bf16_t* V1 = (const bf16_t*)(A->ws + WS_V1);
    const bf16_t* CK1 = (const bf16_t*)(A->ws + WS_CK1); const bf16_t* CV1 = (const bf16_t*)(A->ws + WS_CV1);
    bf16_t* CAT = (bf16_t*)(A->ws + WS_CAT);
    const float* rel_bias = A->in[33];
    LAS float* Bl = (LAS float*)(C.lds + ATT_B_OFF);
    const int bx = blockIdx.x;
    for (int u = bx; u < 512; u += C.G) {
        const int x = u & 7, jj = u >> 3, bh = 4 * x + (jj >> 4), b = bh >> 4, h = bh & 15, rg = jj & 15, r0 = 4 * rg;
        const int kr_lo = r0 - 4 < 0 ? 0 : (r0 - 4 > 56 ? 56 : r0 - 4);
        const int rs_hi = r0 + 3 - 4 < 0 ? 0 : (r0 + 3 - 4 > 56 ? 56 : r0 + 3 - 4);
        const int nLocal = rs_hi + 8 - kr_lo;
        float bias_v = 0.f; { const int i = C.tid, dr = i >> 5, dc = i & 31; if (i < 15 * 32 && dc < 31) bias_v = rel_bias[(size_t)h * 465 + dr * 31 + dc] * LOG2E; }
        __syncthreads();
        if (C.tid < 15 * 32) Bl[C.tid] = bias_v;
        const size_t qrow = (size_t)NPR + (size_t)b * 4096 + (size_t)r0 * 64, krow = (size_t)NPR + (size_t)b * 4096 + (size_t)kr_lo * 64, crow = (size_t)b * 512;
        attn_unit<64, 1, 1024, 1024, 1024, 1024>(C.lds, Q1 + qrow * 1024 + h * 64, K1 + krow * 1024 + h * 64, V1 + krow * 1024 + h * 64, nLocal, CK1 + crow * 1024 + h * 64, CV1 + crow * 1024 + h * 64, nLocal + 8,
                         CAT + qrow * 1024 + h * 64, kr_lo, r0);
    }
    for (int u = bx; u < 256; u += C.G) {
        const int b = u >> 4, h = u & 15; const size_t row = (size_t)b * 256;
        attn_unit<64, 0, 1024, 1024, 1024, 1024>(C.lds, Q1 + row * 1024 + h * 64, K1 + row * 1024 + h * 64, V1 + row * 1024 + h * 64, 4, nullptr, nullptr, 4, CAT + row * 1024 + h * 64, 0, 0);
    }
}

#ifndef PH_MASK
#define PH_MASK 0x3ffff
#endif
#define IN(k) (((PH_MASK >> (k)) & 1) && lo <= (k) && (k) < hi)
#define SEAM(k) do { if (IN(k) && IN((k) + 1)) xcd_barrier(bar); } while (0)
template <int layer> DI void run_layer(const Ctx& C, const XcdBarrier& bar, const int lo, const int hi) {
    const int bx = blockIdx.x, G = C.G;
        const int pb = layer ? 11 : 1;
        if (layer == 0) if (IN(pb)) for (int rep = 0; rep < REP_EW; ++rep) { ArgsP A = get_args(); const float* mod = (const float*)(A->ws + WS_MOD) + (size_t)layer * 3 * 6144;
            phase_modulate(C, A, layer ? A->out : A->in[0], layer ? A->out + (size_t)NPR * DM : A->in[1], layer ? A->in[26] : A->in[10], mod, 0, 1024); }
        if (layer == 0) SEAM(pb);
        if (layer == 0) {
            if (IN(2)) { ArgsP A = get_args(); unsigned char* ws = A->ws;
                pg8::Gemm g{(const bf16_t*)(ws + WS_H), (const bf16_t*)(ws + WS_WIN0), NTOK, 1024, 1024}; pg8::StaticOrder S; S.init(64 * 256, 1024, G, bx);
                pg8::EpiF32<true> E{(float*)(ws + WS_Y0), 1024}; pg8::gemm_phase<pg8::EpiF32<true>, pg8::StaticOrder, true, true, true>(C.lds, g, S, E); }
            SEAM(2);
            if (IN(3)) for (int rep = 0; rep < REP_EW; ++rep) { ArgsP A = get_args(); phase_post_in0(C, A); }
            SEAM(3);
            if (IN(4)) {
                { ArgsP A = get_args(); unsigned char* ws = A->ws;
                  pg8::Gemm g{(const bf16_t*)(ws + WS_QN), (const bf16_t*)(ws + WS_WQUP), NTOK, 768, 256}; pg8::StaticOrder S; S.init(NTOK, 768, G, bx);
                  pg8::EpiB<0> E{(bf16_t*)(ws + WS_QRAW), 768}; pg8::gemm_phase<pg8::EpiB<0>, pg8::StaticOrder, true, true>(C.lds, g, S, E); }
                { ArgsP A = get_args(); unsigned char* ws = A->ws;
                  pg8::Gemm g{(const bf16_t*)(ws + WS_CKVB), (const bf16_t*)(ws + WS_WKVUP), NROWC, 1024, 128}; pg8::StaticOrder S; S.init(NROWC, 1024, G, (bx + G - 144) % G);
                  pg8::EpiB<0> E{(bf16_t*)(ws + WS_KVRAW), 1024}; pg8::gemm_phase<pg8::EpiB<0>, pg8::StaticOrder, true, true>(C.lds, g, S, E); }
                { ArgsP A = get_args(); unsigned char* ws = A->ws;
                  pg8::Gemm g{(const bf16_t*)(ws + WS_POOLED), (const bf16_t*)(ws + WS_WPOOL), NTOK, 512, 512}; pg8::StaticOrder S; S.init(NTOK, 512, G, (bx + G - 96) % G);
                  pg8::EpiB<0> E{(bf16_t*)(ws + WS_CAT), 1024}; pg8::gemm_phase<pg8::EpiB<0>, pg8::StaticOrder, true, true>(C.lds, g, S, E); }
                { ArgsP A = get_args(); unsigned char* ws = A->ws;
                  deferred_transposes<0>(C, A, 192);
                  if (bx >= 192) gemv_sh_unit<false>(C, A->in[12], 4096, (const float*)(ws + WS_MOD) + 3072, (float*)(ws + WS_SHW1), bx - 192); }
            }
            SEAM(4);
            if (IN(5)) for (int rep = 0; rep < REP_EW; ++rep) { ArgsP A = get_args(); phase_mla_finish(C, A); }
            SEAM(5);
            if (IN(6)) for (int rep = 0; rep < REP_ATT; ++rep) { ArgsP A = get_args(); phase_mla_attn(C, A);
                __syncthreads();
                deferred_transposes<1>(C, A, 128);
                if (bx >= 128) { unsigned char* ws = A->ws; const float* mod1 = (const float*)(ws + WS_MOD) + (size_t)3 * 6144; const int uu = bx - 128;
                    if (uu < 48) gemv_sh_unit<true>(C, A->in[30], 3072, mod1 + 0, (float*)(ws + WS_SHWIN), uu);
                    else if (uu < 112) gemv_sh_unit<false>(C, A->in[28], 4096, mod1 + 3072, (float*)(ws + WS_SHW1) + 3 * 4096, uu - 48); } }
            SEAM(6);
        } else {
            if (IN(12)) { ArgsP A = get_args(); unsigned char* ws = A->ws;
                pg8::Gemm g{(const bf16_t*)(ws + WS_H), (const bf16_t*)(ws + WS_WIN1), NTOK, 3072, 1024}; pg8::StaticOrder S; S.init(64 * 256, 3072, G, bx);
                pg8::EpiQKV<true> E{(bf16_t*)(ws + WS_Q1), A->out + OUT_NAK, (const float*)(ws + WS_MOD + 256 * 1024), 0.125f * LOG2E, (const float*)(ws + WS_ROWP), (const float*)(ws + WS_SHWIN)};
                pg8::gemm_phase<pg8::EpiQKV<true>, pg8::StaticOrder, true, true, true>(C.lds, g, S, E); }
            SEAM(12);
            if (IN(13)) for (int rep = 0; rep < REP_ATT; ++rep) { ArgsP A = get_args(); phase_na_attn(C, A); }
            SEAM(13);
        }
        const int po = layer ? 14 : 7;
        if (IN(po)) { ArgsP A = get_args(); unsigned char* ws = A->ws; const float* mod = (const float*)(ws + WS_MOD) + (size_t)layer * 3 * 6144;
            pg8::Gemm g{(const bf16_t*)(ws + WS_CAT), (const bf16_t*)(ws + (layer ? WS_WOUT1 : WS_WOUT0)), NTOK, 1024, 1024}; pg8::StaticOrder S; S.init(64 * 256, 1024, G, bx);
            pg8::EpiRes<true, true> E{layer ? A->out : A->in[0], layer ? A->out + (size_t)NPR * DM : A->in[1], A->out, mod + 2048,
                                (bf16_t*)(ws + WS_H), layer ? A->in[27] : A->in[11], mod + 4096, (float*)(ws + WS_ROWP)};
            pg8::gemm_phase<pg8::EpiRes<true, true>, pg8::StaticOrder, true, true, true>(C.lds, g, S, E); }
        SEAM(po);
        if (IN(po + 2)) for (int rep = 0; rep < REP_MLP1; ++rep) { ArgsP A = get_args(); unsigned char* ws = A->ws;
            pg8::Gemm g{(const bf16_t*)(ws + WS_H), (const bf16_t*)(ws + (layer ? WS_W1_1 : WS_W1_0)), NTOK, FF, 1024}; pg8::StaticOrder S; S.init(NTOK, FF, G, bx);
            pg8::EpiMlp1 E{(bf16_t*)(ws + WS_U), FF, (const float*)(ws + WS_ROWP), (const float*)(ws + WS_SHW1) + (size_t)layer * 3 * 4096}; pg8::gemm_phase<pg8::EpiMlp1, pg8::StaticOrder, true, true>(C.lds, g, S, E); }
        SEAM(po + 2);
        if (IN(po + 3)) { ArgsP A = get_args(); unsigned char* ws = A->ws; const float* mod = (const float*)(ws + WS_MOD) + (size_t)layer * 3 * 6144;
            pg8::Gemm g{(const bf16_t*)(ws + WS_U), (const bf16_t*)(ws + (layer ? WS_W2_1 : WS_W2_0)), NTOK, 1024, FF}; pg8::StaticOrder S; S.init(64 * 256, 1024, G, bx);
            if (layer == 0) { pg8::EpiRes<true, true> E{A->out, A->out + (size_t)NPR * DM, A->out, mod + 5120, (bf16_t*)(ws + WS_H), A->in[26], mod + (size_t)3 * 6144 + 1024, (float*)(ws + WS_ROWP)};
                pg8::gemm_phase<pg8::EpiRes<true, true>, pg8::StaticOrder, true, true, true>(C.lds, g, S, E); deferred_transposes<2>(C, A, 0); }
            else { pg8::EpiRes<false, true> E{A->out, A->out + (size_t)NPR * DM, A->out, mod + 5120, nullptr, nullptr, nullptr, nullptr};
                pg8::gemm_phase<pg8::EpiRes<false, true>, pg8::StaticOrder, true, true, true>(C.lds, g, S, E); } }
        SEAM(po + 3);
    }

constexpr int NPHASE = 18;
__global__ void __launch_bounds__(NTHREADS, 2) fwd_kernel(Args args) {
    extern __shared__ __attribute__((aligned(16))) unsigned char lds_raw[];
    Ctx C;
    C.lds = (LAS unsigned char*)lds_raw;
    C.tid = threadIdx.x; C.lane = C.tid & 63; C.wave = __builtin_amdgcn_readfirstlane(C.tid >> 6); C.G = gridDim.x;
    const int lo = args.ph_lo, hi = args.ph_hi;
    volatile LAS unsigned* bst = (volatile LAS unsigned*)(C.lds + 131072 + 1024);
    if (C.tid < 2) bst[C.tid] = 0u;
    __syncthreads();
    XcdBarrier bar; bar.bar = (unsigned*)args.ws; bar.x = 0; bar.st = bst;
    if (hi - lo > 1) bar = xcd_barrier_post((unsigned*)args.ws, bst);
    if (hi > 1000) cg::this_grid().sync();
    if (IN(0)) for (int rep = 0; rep < REP_P0; ++rep) { ArgsP A = get_args(); phase_prologue(C, A); if (rep + 1 < REP_P0) __syncthreads(); }
    for (int rep = 0; rep < REP_SYNC; ++rep) cg::this_grid().sync();
    SEAM(0);
    run_layer<0>(C, bar, lo, hi);
    run_layer<1>(C, bar, lo, hi);
#undef IN
#undef SEAM
}

extern "C" void kernel_launch(void* const* d_in, const int* in_sizes, int n_in, void* d_out, int out_size, void* d_ws, size_t ws_size, hipStream_t stream) {
    static int grid = 0;
    if (grid == 0) {
        int dev = 0, cus = 0, per_cu = 0;
        if (hipGetDevice(&dev) != hipSuccess || hipDeviceGetAttribute(&cus, hipDeviceAttributeMultiprocessorCount, dev) != hipSuccess) { fprintf(stderr, "kernel_launch: device query failed\n"); grid = -1; return; }
        if (hipFuncSetAttribute((const void*)fwd_kernel, hipFuncAttributeMaxDynamicSharedMemorySize, LDS_BYTES) != hipSuccess) { fprintf(stderr, "kernel_launch: hipFuncSetAttribute failed\n"); grid = -1; return; }
        if (hipOccupancyMaxActiveBlocksPerMultiprocessor(&per_cu, (const void*)fwd_kernel, NTHREADS, LDS_BYTES) != hipSuccess || per_cu < 1) { fprintf(stderr, "kernel_launch: occupancy query gave %d\n", per_cu); per_cu = 1; }
        (void)hipGetLastError();
        grid = cus;
    }
    if (grid < 0) return;
    Args a{};
    for (int i = 0; i < 35; ++i) a.in[i] = (const float*)d_in[i];
    a.out = (float*)d_out; a.ws = (unsigned char*)d_ws;
#if MK_PER_PHASE
#ifndef NPH_RUN
#define NPH_RUN NPHASE
#endif
    for (int p = 0; p < NPH_RUN; ++p) { a.ph_lo = p; a.ph_hi = p + 1; hipLaunchKernelGGL(fwd_kernel, dim3(grid), dim3(NTHREADS), LDS_BYTES, stream, a); }
#else
    if (hipMemsetAsync(d_ws, 0, 16384, stream) != hipSuccess) { fprintf(stderr, "kernel_launch: hipMemsetAsync failed\n"); return; }
    a.ph_lo = 0; a.ph_hi = NPHASE;
    void* kargs[] = {&a};
    hipError_t e = hipLaunchCooperativeKernel((const void*)fwd_kernel, dim3(grid), dim3(NTHREADS), kargs, LDS_BYTES, stream);
    if (e != hipSuccess) fprintf(stderr, "kernel_launch: cooperative launch failed: %s (grid %d)\n", hipGetErrorString(e), grid);
#endif
}
```

```cpp
#include <hip/hip_runtime.h>
#include <hip/hip_cooperative_groups.h>
#include <cstdio>
#include <cstdint>
namespace cg = cooperative_groups;

#define P0_PARTS 7
#define TR_MASK 0x7ff
#ifndef REP_ATT
#define REP_ATT 1
#endif
#ifndef REP_MLP1
#define REP_MLP1 1
#endif
#ifndef REP_EW
#define REP_EW 1
#endif
#ifndef REP_P0
#define REP_P0 1
#endif
#ifndef REP_SYNC
#define REP_SYNC 0
#endif
#ifndef MK_PER_PHASE
#define MK_PER_PHASE 0
#endif

namespace pg8 {
#define PG8_LAS __attribute__((address_space(3)))
typedef unsigned short bf16_t;
typedef short bf16x8 __attribute__((ext_vector_type(8)));
typedef float f32x4 __attribute__((ext_vector_type(4)));
typedef unsigned u32x4 __attribute__((ext_vector_type(4)));
constexpr int BM = 256, BK = 64, HALF = 128, HTB = HALF * BK * 2  , STAGE_BYTES = 8 * HTB, NXCD = 8, WGM = 8;

__host__ __device__ __forceinline__ int lds_byte(int r, int c) { const int st = (r >> 4) * 2 + (c >> 5), rr = r & 15, cc = c & 31, ob = rr * 64 + cc * 2; return st * 1024 + (ob ^ (((ob >> 9) & 1) << 5)); }
__host__ __device__ __forceinline__ void stage_rc(int b, int& R, int& C) { const int st = b / 1024, sb = b % 1024, swz = sb ^ (((sb >> 9) & 1) << 5); R = (st >> 1) * 16 + swz / 64; C = (st & 1) * 32 + (swz % 64) / 2; }
__host__ __device__ __forceinline__ int perm32(int rho) { const int n = rho >> 4, i = rho & 15; return 8 * (i >> 2) + 4 * n + (i & 3); }

struct Unit { int pm, pn; };
struct Gemm { const bf16_t* A; const bf16_t* Bt; int M, N, K; };

struct StaticOrder {
    int nM, nN, nwg, G, c;
    __host__ __device__ void init(int M, int N, int G_, int c_) { nM = M / BM; nN = N / BM; nwg = nM * nN; G = G_; c = c_; }
    __host__ __device__ bool next(int i, Unit& u) const {
        const long L = (long)i * G + c; if (L >= nwg) return false;
        int wgid = (int)L; { const int q = nwg / NXCD, r = nwg % NXCD, xcd = wgid % NXCD, off = wgid / NXCD; wgid = (xcd < r ? xcd * (q + 1) : r * (q + 1) + (xcd - r) * q) + off; }
        const int nig = WGM * nN, gid = wgid / nig, fm = gid * WGM, gsz = (nM - fm) < WGM ? (nM - fm) : WGM;
        u.pm = fm + ((wgid % nig) % gsz); u.pn = (wgid % nig) / gsz; return true;
    }
    __device__ __forceinline__ void a_ready(const Unit&) const {}
    __device__ __forceinline__ void done(const Unit&) const {}
};

typedef float f32x2 __attribute__((ext_vector_type(2)));
typedef __bf16 bf16x2v __attribute__((ext_vector_type(2)));
typedef unsigned u32x2v __attribute__((ext_vector_type(2)));
__device__ __forceinline__ unsigned pk2(float lo, float hi) { f32x2 v = {lo, hi}; bf16x2v r = __builtin_convertvector(v, bf16x2v); return __builtin_bit_cast(unsigned, r); }
typedef unsigned u32x2p __attribute__((ext_vector_type(2)));
__device__ __forceinline__ float xadd16(float x) { const unsigned u = __float_as_uint(x); const u32x2p r = __builtin_amdgcn_permlane16_swap(u, u, false, false); return __uint_as_float(r[0]) + __uint_as_float(r[1]); }
__device__ __forceinline__ float xadd32(float x) { const unsigned u = __float_as_uint(x); const u32x2p r = __builtin_amdgcn_permlane32_swap(u, u, false, false); return __uint_as_float(r[0]) + __uint_as_float(r[1]); }
__device__ __forceinline__ float xmax32(float x) { const unsigned u = __float_as_uint(x); const u32x2p r = __builtin_amdgcn_permlane32_swap(u, u, false, false); return fmaxf(__uint_as_float(r[0]), __uint_as_float(r[1])); }
__device__ __forceinline__ float dpp_xadd1(float x) { return x + __uint_as_float(__builtin_amdgcn_mov_dpp(__float_as_uint(x), 0xB1, 0xF, 0xF, true)); }
__device__ __forceinline__ float dpp_xadd2(float x) { return x + __uint_as_float(__builtin_amdgcn_mov_dpp(__float_as_uint(x), 0x4E, 0xF, 0xF, true)); }
__device__ __forceinline__ float dpp_hmadd(float x) { return x + __uint_as_float(__builtin_amdgcn_mov_dpp(__float_as_uint(x), 0x141, 0xF, 0xF, true)); }
__device__ __forceinline__ float dpp_rmadd(float x) { return x + __uint_as_float(__builtin_amdgcn_mov_dpp(__float_as_uint(x), 0x140, 0xF, 0xF, true)); }

template <int ACT> struct EpiB {
    static constexpr bool PERM = true, AFTER_DRAIN = false;
    bf16_t* O; int ldc;
    __device__ __forceinline__ void operator()(const f32x4 (&acc)[2][2][4][2], const Unit& u, int wr, int wc, int fr, int fq) const {
        const int row0 = u.pm * BM + wr * 64 + fr, col0 = u.pn * BM + wc * 32 + 8 * fq;
#pragma unroll
        for (int ai = 0; ai < 2; ++ai)
#pragma unroll
            for (int m = 0; m < 4; ++m) { bf16_t* rowp = O + (size_t)(row0 + ai * HALF + m * 16) * ldc + col0;
#pragma unroll
                for (int bj = 0; bj < 2; ++bj) { f32x4 v0 = acc[ai][bj][m][0], v1 = acc[ai][bj][m][1];
                    if (ACT == 2) { v0 = __builtin_elementwise_max(v0, (f32x4){0.f, 0.f, 0.f, 0.f}); v1 = __builtin_elementwise_max(v1, (f32x4){0.f, 0.f, 0.f, 0.f}); v0 = v0 * v0; v1 = v1 * v1; }
                    u32x4 w; w.x = pk2(v0[0], v0[1]); w.y = pk2(v0[2], v0[3]); w.z = pk2(v1[0], v1[1]); w.w = pk2(v1[2], v1[3]);
                    *(u32x4*)(rowp + bj * HALF) = w; } }
    }
};
template <bool M3_ = false> struct EpiF32 {
    static constexpr bool PERM = false, AFTER_DRAIN = false, M3 = M3_;
    float* O; int ldc;
    __device__ __forceinline__ void operator()(const f32x4 (&acc)[2][2][4][2], const Unit& u, int wr, int wc, int fr, int fq) const {
        const int row0 = M3 ? u.pm * 192 + wr * 48 + fr : u.pm * BM + wr * 64 + fr, col0 = u.pn * BM + wc * 32 + 4 * fq;
#pragma unroll
        for (int ai = 0; ai < 2; ++ai)
#pragma unroll
            for (int m = 0; m < (M3 ? 3 : 4); ++m) { float* rowp = O + (size_t)(row0 + ai * (M3 ? 96 : HALF) + m * 16) * ldc + col0;
#pragma unroll
                for (int bj = 0; bj < 2; ++bj)
#pragma unroll
                    for (int n = 0; n < 2; ++n) *(f32x4*)(rowp + bj * HALF + n * 16) = acc[ai][bj][m][n]; }
    }
};
template <bool XG, bool M3_ = false> struct EpiRes {
    static constexpr bool PERM = false, AFTER_DRAIN = false, M3 = M3_;
    const float* base0; const float* base1; float* out; const float* gate;
    bf16_t* H; const float* normw; const float* scv; float* rowp;
    template <bool PERGROUP> __device__ __forceinline__ void rows(const f32x4 (&acc)[2][2][4][2], const Unit& u, int wr, int wc, int fr, int fq) const {
        constexpr int MG = M3 ? 3 : 4, NG = 2 * MG, AS = M3 ? 96 : HALF;
        const int row0 = M3 ? u.pm * 192 + wr * 48 + fr : u.pm * BM + wr * 64 + fr, col0 = u.pn * BM + wc * 32 + 4 * fq;
        f32x4 gv[2][2], gx[2][2], nw[2][2];
        if (XG) {
#pragma unroll
            for (int bj = 0; bj < 2; ++bj)
#pragma unroll
                for (int n = 0; n < 2; ++n) nw[bj][n] = *(const f32x4*)(normw + col0 + bj * HALF + n * 16); }
        if (!PERGROUP) { const size_t mo = (size_t)((M3 ? u.pm * 192 : u.pm * BM) >> 12) * 6144 + col0;
#pragma unroll
            for (int bj = 0; bj < 2; ++bj)
#pragma unroll
                for (int n = 0; n < 2; ++n) { gv[bj][n] = *(const f32x4*)(gate + mo + bj * HALF + n * 16);
                    if (XG) gx[bj][n] = nw[bj][n] * (*(const f32x4*)(scv + mo + bj * HALF + n * 16) + 1.f); } }
        f32x4 bq[2][4];
        { const int row = row0; const float* bb = (row < 4096) ? base0 : base1 - (size_t)4096 * 1024;
#pragma unroll
          for (int e = 0; e < 4; ++e) bq[0][e] = *(const f32x4*)(bb + (size_t)row * 1024 + col0 + (e >> 1) * HALF + (e & 1) * 16); }
#pragma unroll
        for (int gi = 0; gi < NG; ++gi) { const int ai = gi / MG, m = gi % MG; const int row = row0 + ai * AS + m * 16; const size_t off = (size_t)row * 1024 + col0; float ss = 0.f;
            if (gi + 1 < NG) { const int rn = row0 + ((gi + 1) / MG) * AS + ((gi + 1) % MG) * 16; const float* bn = (rn < 4096) ? base0 : base1 - (size_t)4096 * 1024;
#pragma unroll
                for (int e = 0; e < 4; ++e) bq[(gi + 1) & 1][e] = *(const f32x4*)(bn + (size_t)rn * 1024 + col0 + (e >> 1) * HALF + (e & 1) * 16); }
            if (PERGROUP) { const size_t mo = (size_t)(row >> 12) * 6144 + col0;
#pragma unroll
                for (int bj = 0; bj < 2; ++bj)
#pragma unroll
                    for (int n = 0; n < 2; ++n) { gv[bj][n] = *(const f32x4*)(gate + mo + bj * HALF + n * 16);
                        if (XG) gx[bj][n] = nw[bj][n] * (*(const f32x4*)(scv + mo + bj * HALF + n * 16) + 1.f); } }
#pragma unroll
            for (int bj = 0; bj < 2; ++bj)
#pragma unroll
                for (int n = 0; n < 2; ++n) { const f32x4 b = bq[gi & 1][bj * 2 + n];
                    const f32x4 o = b + gv[bj][n] * acc[ai][bj][m][n];
                    *(f32x4*)(out + off + bj * HALF + n * 16) = o;
                    if (XG) { const f32x4 xg = o * gx[bj][n]; u32x2v w; w.x = pk2(xg[0], xg[1]); w.y = pk2(xg[2], xg[3]); *(u32x2v*)(H + off + bj * HALF + n * 16) = w;
                        ss += (o[0] * o[0] + o[1] * o[1]) + (o[2] * o[2] + o[3] * o[3]); } }
            if (XG) { ss = xadd32(xadd16(ss)); if (fq == 0) rowp[(size_t)row * 16 + u.pn * 4 + wc] = ss; } }
    }
    __device__ __forceinline__ void operator()(const f32x4 (&acc)[2][2][4][2], const Unit& u, int wr, int wc, int fr, int fq) const {
        const bool straddle = M3 && (((u.pm * 192) >> 12) != ((u.pm * 192 + 191) >> 12));
        if (straddle) rows<true>(acc, u, wr, wc, fr, fq); else rows<false>(acc, u, wr, wc, fr, fq);
    }
};
__device__ __forceinline__ float row_rstd(const float* rowp, int row) {
    const f32x4* p = (const f32x4*)(rowp + (size_t)row * 16); const f32x4 a = p[0], b = p[1], c = p[2], d = p[3];
    const float s = ((a[0] + a[1]) + (a[2] + a[3])) + ((b[0] + b[1]) + (b[2] + b[3])) + ((c[0] + c[1]) + (c[2] + c[3])) + ((d[0] + d[1]) + (d[2] + d[3]));
    return __builtin_amdgcn_rsqf(s * (1.f / 1024.f) + 1e-6f);
}
__device__ __forceinline__ float rstd_from_quarter(const f32x4 q) {
    float s = (q[0] + q[1]) + (q[2] + q[3]); s = xadd32(xadd16(s));
    return __builtin_amdgcn_rsqf(s * (1.f / 1024.f) + 1e-6f);
}
struct EpiMlp1 {
    static constexpr bool PERM = true, AFTER_DRAIN = false;
    bf16_t* O; int ldc; const float* rowp; const float* shw;
    __device__ __forceinline__ void operator()(const f32x4 (&acc)[2][2][4][2], const Unit& u, int wr, int wc, int fr, int fq) const {
        const int row0 = u.pm * BM + wr * 64 + fr, col0 = u.pn * BM + wc * 32 + 8 * fq;
        const float* sw = shw + (size_t)(u.pm >> 4) * ldc + col0;
        f32x4 sv[2][2];
#pragma unroll
        for (int bj = 0; bj < 2; ++bj)
#pragma unroll
            for (int n = 0; n < 2; ++n) sv[bj][n] = *(const f32x4*)(sw + bj * HALF + 4 * n);
        f32x4 rq[2][4];
#pragma unroll
        for (int ai = 0; ai < 2; ++ai)
#pragma unroll
            for (int m = 0; m < 4; ++m) rq[ai][m] = *(const f32x4*)(rowp + (size_t)(row0 + ai * HALF + m * 16) * 16 + 4 * fq);
#pragma unroll
        for (int ai = 0; ai < 2; ++ai)
#pragma unroll
            for (int m = 0; m < 4; ++m) { const int row = row0 + ai * HALF + m * 16; const float rstd = rstd_from_quarter(rq[ai][m]); bf16_t* rowq = O + (size_t)row * ldc + col0;
#pragma unroll
                for (int bj = 0; bj < 2; ++bj) { f32x4 v0 = acc[ai][bj][m][0] * rstd + sv[bj][0], v1 = acc[ai][bj][m][1] * rstd + sv[bj][1];
                    v0 = __builtin_elementwise_max(v0, (f32x4){0.f, 0.f, 0.f, 0.f}); v1 = __builtin_elementwise_max(v1, (f32x4){0.f, 0.f, 0.f, 0.f}); v0 = v0 * v0; v1 = v1 * v1;
                    u32x4 w; w.x = pk2(v0[0], v0[1]); w.y = pk2(v0[2], v0[3]); w.z = pk2(v1[0], v1[1]); w.w = pk2(v1[2], v1[3]);
                    *(u32x4*)(rowq + bj * HALF) = w; } }
    }
};
template <bool M3_ = false> struct EpiQKV {
    static constexpr bool PERM = true, AFTER_DRAIN = false, M3 = M3_;
    bf16_t* Q1; float* outK; const float* qn; float qscale; const float* rowp; const float* shw;
    __device__ __forceinline__ void operator()(const f32x4 (&acc)[2][2][4][2], const Unit& u, int wr, int wc, int fr, int fq) const {
        const int sect = u.pn >> 2, head = (u.pn & 3) * 4 + wc;
        const int row0 = M3 ? u.pm * 192 + wr * 48 + fr : u.pm * BM + wr * 64 + fr, dcol = head * 64 + 8 * fq;
        bf16_t* dst = Q1 + (size_t)sect * 12582912;
        float* fo = outK + (size_t)(sect == 2 ? 4194304 : 0);
        const float* nw = qn + (sect == 0 ? 0 : 64);
        f32x4 wv[2][2];
#pragma unroll
        for (int bj = 0; bj < 2; ++bj)
#pragma unroll
            for (int n = 0; n < 2; ++n) wv[bj][n] = *(const f32x4*)(nw + 32 * bj + 8 * fq + 4 * n);
        const float sc = sect == 0 ? qscale : 1.f;
        f32x4 shv[2][2];
        const int scol = u.pn * BM + 32 * wc + 8 * fq;
        const bool straddle = M3 && (((u.pm * 192) >> 12) != ((u.pm * 192 + 191) >> 12));
        if (!straddle) { const size_t mo = (size_t)((M3 ? u.pm * 192 : u.pm * BM) >> 12) * 3072;
#pragma unroll
            for (int bj = 0; bj < 2; ++bj)
#pragma unroll
                for (int n = 0; n < 2; ++n) shv[bj][n] = *(const f32x4*)(shw + mo + scol + 128 * bj + 4 * n); }
        f32x4 rq[2][4];
#pragma unroll
        for (int ai = 0; ai < 2; ++ai)
#pragma unroll
            for (int m = 0; m < (M3 ? 3 : 4); ++m) rq[ai][m] = *(const f32x4*)(rowp + (size_t)(row0 + ai * (M3 ? 96 : HALF) + m * 16) * 16 + 4 * fq);
#pragma unroll
        for (int ai = 0; ai < 2; ++ai)
#pragma unroll
            for (int m = 0; m < (M3 ? 3 : 4); ++m) {
                const int row = row0 + ai * (M3 ? 96 : HALF) + m * 16;
                const float rstd_in = rstd_from_quarter(rq[ai][m]);
                if (straddle) {
#pragma unroll
                    for (int bj = 0; bj < 2; ++bj)
#pragma unroll
                        for (int n = 0; n < 2; ++n) shv[bj][n] = *(const f32x4*)(shw + (size_t)(row >> 12) * 3072 + scol + 128 * bj + 4 * n); }
                f32x4 v[2][2];
#pragma unroll
                for (int bj = 0; bj < 2; ++bj)
#pragma unroll
                    for (int n = 0; n < 2; ++n) v[bj][n] = acc[ai][bj][m][n] * rstd_in + shv[bj][n];
                if (sect < 2) {
                    float ss = 0.f;
#pragma unroll
                    for (int bj = 0; bj < 2; ++bj)
#pragma unroll
                        for (int n = 0; n < 2; ++n) { const f32x4 x = v[bj][n]; ss += (x[0] * x[0] + x[1] * x[1]) + (x[2] * x[2] + x[3] * x[3]); }
                    ss = xadd32(xadd16(ss));
                    const float rstd = __builtin_amdgcn_rsqf(ss * (1.f / 64.f) + 1e-6f) * sc;
#pragma unroll
                    for (int bj = 0; bj < 2; ++bj)
#pragma unroll
                        for (int n = 0; n < 2; ++n) v[bj][n] = v[bj][n] * rstd * wv[bj][n];
                }
#pragma unroll
                for (int bj = 0; bj < 2; ++bj) {
                    u32x4 w; w.x = pk2(v[bj][0][0], v[bj][0][1]); w.y = pk2(v[bj][0][2], v[bj][0][3]); w.z = pk2(v[bj][1][0], v[bj][1][1]); w.w = pk2(v[bj][1][2], v[bj][1][3]);
                    *(u32x4*)(dst + (size_t)row * 1024 + dcol + 32 * bj) = w;
                    if (sect >= 1 && row < 4096) { float* fp = fo + (size_t)row * 1024 + dcol + 32 * bj; *(f32x4*)fp = v[bj][0]; *(f32x4*)(fp + 4) = v[bj][1]; }
                }
            }
    }
};

template <class Epi, class Sched, bool ALIGN_EPI = false, bool SP2 = false, bool M3 = false>
__device__ __forceinline__ void gemm_phase(PG8_LAS unsigned char* lds, const Gemm g, const Sched& S, const Epi& E) {
    int tid_ = threadIdx.x; asm volatile("" : "+v"(tid_));
    const int tid = tid_, wid = __builtin_amdgcn_readfirstlane(tid >> 6), lane = tid & 63, wr = wid >> 2, wc = wid & 3, fr = lane & 15, fq = lane >> 4;
    int K_ = g.K; asm volatile("" : "+s"(K_));
    const int K = K_, nt = K / BK;
    unsigned voffA[2], voffB[2];
#pragma unroll
    for (int i = 0; i < 2; ++i) { int R, C; stage_rc(tid * 16 + i * 8192, R, C); const int Rb = Epi::PERM ? ((R & ~31) + perm32(R & 31)) : R;
        const int Ra = M3 ? ((R >> 6) * 48 + (((R >> 4) & 3) > 2 ? 2 : ((R >> 4) & 3)) * 16 + (R & 15)) : R;
        voffA[i] = (unsigned)(Ra * K + C) * 2u; voffB[i] = (unsigned)(Rb * K + C) * 2u; }
    const size_t kstep = (size_t)(BK * 2);
    const size_t hstep = (size_t)HALF * K * 2;
    const size_t tstep = 2 * hstep;
    const size_t hstepA = M3 ? (size_t)96 * K * 2 : hstep, tstepA = 2 * hstepA;
    const unsigned ldsw = (unsigned)wid * 1024u;
    const int aoff = lds_byte(wr * 64 + fr, fq * 8), boff = lds_byte(wc * 32 + fr, fq * 8);
#define PG8_SA(b, h) (((b) * 2 + (h)) * HTB)
#define PG8_SB(b, h) ((4 + (b) * 2 + (h)) * HTB)
#define PG8_STAGE(bufoff, gbase, voff) do { _Pragma("unroll") for (int _i = 0; _i < 2; ++_i) \
        __builtin_amdgcn_global_load_lds((const unsigned*)((const char*)(gbase) + (voff)[_i]), (PG8_LAS unsigned*)(lds + (bufoff) + ldsw + _i * 8192), 16, 0, 0); } while (0)
#define PG8_LDA(dst, b, h) do { _Pragma("unroll") for (int m = 0; m < (M3 ? 3 : 4); ++m) _Pragma("unroll") for (int k = 0; k < 2; ++k) dst[m][k] = *(const PG8_LAS bf16x8*)(lds + PG8_SA(b, h) + aoff + m * 2048 + k * 1024); } while (0)
#define PG8_LDB(dst, b, h) do { _Pragma("unroll") for (int n = 0; n < 2; ++n) _Pragma("unroll") for (int k = 0; k < 2; ++k) dst[n][k] = *(const PG8_LAS bf16x8*)(lds + PG8_SB(b, h) + boff + n * 2048 + k * 1024); } while (0)
#define PG8_MMA(ai, bj, At, Bt) do { __builtin_amdgcn_s_setprio(1); _Pragma("unroll") for (int m = 0; m < (M3 ? 3 : 4); ++m) _Pragma("unroll") for (int n = 0; n < 2; ++n) _Pragma("unroll") for (int k = 0; k < 2; ++k) \
        acc[ai][bj][m][n] = __builtin_amdgcn_mfma_f32_16x16x32_bf16(Bt[n][k], At[m][k], acc[ai][bj][m][n], 0, 0, 0); __builtin_amdgcn_s_setprio(0); } while (0)
#define PG8_WAIT_V(n) asm volatile("s_waitcnt vmcnt(" #n ")" ::: "memory")
#define PG8_WAIT_L(n) asm volatile("s_waitcnt lgkmcnt(" #n ")" ::: "memory")
#define PG8_BAR __builtin_amdgcn_s_barrier()
#define PG8_SCHED __builtin_amdgcn_sched_barrier(0)
    Unit cur, nxt; int ui = 0;
    if (!S.next(0, cur)) return;
    f32x4 acc[2][2][4][2];
#pragma unroll
    for (int a = 0; a < 2; ++a)
#pragma unroll
        for (int b = 0; b < 2; ++b)
#pragma unroll
            for (int m = 0; m < 4; ++m)
#pragma unroll
                for (int n = 0; n < 2; ++n) acc[a][b][m][n] = (f32x4){0.f, 0.f, 0.f, 0.f};
    bf16x8 At[4][2], B0[2][2], B1[2][2];
    const char* cA = (const char*)g.A + (size_t)cur.pm * tstepA; const char* cB = (const char*)g.Bt + (size_t)cur.pn * tstep;
    S.a_ready(cur);
    if constexpr (SP2) {
        PG8_STAGE(PG8_SB(0, 0), cB, voffB); PG8_STAGE(PG8_SB(0, 1), cB + hstep, voffB); PG8_STAGE(PG8_SA(0, 0), cA, voffA); PG8_STAGE(PG8_SA(0, 1), cA + hstepA, voffA);
        if (wr == 1) PG8_BAR;
        PG8_WAIT_V(2); PG8_BAR;
        PG8_STAGE(PG8_SB(1, 0), cB + kstep, voffB); PG8_STAGE(PG8_SA(1, 0), cA + kstep, voffA); PG8_STAGE(PG8_SB(1, 1), cB + hstep + kstep, voffB);
        PG8_WAIT_V(6); PG8_BAR;
    } else {
        PG8_STAGE(PG8_SB(0, 0), cB, voffB); PG8_STAGE(PG8_SA(0, 0), cA, voffA); PG8_STAGE(PG8_SB(0, 1), cB + hstep, voffB); PG8_STAGE(PG8_SA(0, 1), cA + hstepA, voffA);
        if (wr == 1) PG8_BAR;
        PG8_WAIT_V(4); PG8_BAR;
        PG8_STAGE(PG8_SB(1, 0), cB + kstep, voffB); PG8_STAGE(PG8_SA(1, 0), cA + kstep, voffA); PG8_STAGE(PG8_SB(1, 1), cB + hstep + kstep, voffB);
        PG8_WAIT_V(6); PG8_BAR;
    }
    for (;;) {
        const bool has_next = S.next(ui + 1, nxt);
        const char* nA = has_next ? (const char*)g.A + (size_t)nxt.pm * tstepA : cA; const char* nB = has_next ? (const char*)g.Bt + (size_t)nxt.pn * tstep : cB;
        for (int t = 0; t < nt; t += 2) {
            const bool last = (t == nt - 2);
            const char* a1 = cA + (size_t)(t + 1) * kstep;
            const char* a2 = last ? nA : cA + (size_t)(t + 2) * kstep; const char* b2 = last ? nB : cB + (size_t)(t + 2) * kstep;
            const char* a3 = a2 + kstep; const char* b3 = b2 + kstep;
            if (last && has_next) S.a_ready(nxt);
            if constexpr (SP2) {
            PG8_LDB(B0, 0, 0); PG8_LDB(B1, 0, 1); PG8_SCHED; PG8_LDA(At, 0, 0); PG8_STAGE(PG8_SA(1, 1), a1 + hstepA, voffA);
            PG8_WAIT_V(8); PG8_WAIT_L(0); PG8_BAR; PG8_MMA(0, 0, At, B0); PG8_MMA(0, 1, At, B1); PG8_BAR; PG8_SCHED;
            PG8_LDA(At, 0, 1); PG8_STAGE(PG8_SB(0, 0), b2, voffB); PG8_STAGE(PG8_SB(0, 1), b2 + hstep, voffB); PG8_STAGE(PG8_SA(0, 0), a2, voffA);
            PG8_WAIT_V(8); PG8_WAIT_L(0); PG8_BAR; PG8_MMA(1, 0, At, B0); PG8_MMA(1, 1, At, B1); PG8_BAR; PG8_SCHED;
            PG8_LDB(B0, 1, 0); PG8_LDB(B1, 1, 1); PG8_SCHED; PG8_LDA(At, 1, 0); PG8_STAGE(PG8_SA(0, 1), a2 + hstepA, voffA);
            PG8_WAIT_V(8); PG8_WAIT_L(0); PG8_BAR; PG8_MMA(0, 0, At, B0); PG8_MMA(0, 1, At, B1); PG8_BAR; PG8_SCHED;
            PG8_LDA(At, 1, 1); PG8_STAGE(PG8_SB(1, 0), b3, voffB); PG8_STAGE(PG8_SB(1, 1), b3 + hstep, voffB); PG8_STAGE(PG8_SA(1, 0), a3, voffA);
            PG8_WAIT_V(8); PG8_WAIT_L(0); PG8_BAR; PG8_MMA(1, 0, At, B0); PG8_MMA(1, 1, At, B1); PG8_BAR; PG8_SCHED;
            } else {
            PG8_LDB(B0, 0, 0); PG8_SCHED; PG8_LDA(At, 0, 0); PG8_STAGE(PG8_SA(1, 1), a1 + hstepA, voffA);
            PG8_WAIT_L(8); PG8_BAR; PG8_WAIT_L(0); PG8_MMA(0, 0, At, B0); PG8_BAR; PG8_SCHED;
            PG8_LDB(B1, 0, 1); PG8_STAGE(PG8_SB(0, 0), b2, voffB);
            PG8_BAR; PG8_WAIT_L(0); PG8_MMA(0, 1, At, B1); PG8_BAR;
            PG8_LDA(At, 0, 1); PG8_STAGE(PG8_SA(0, 0), a2, voffA);
            PG8_BAR; PG8_WAIT_L(0); PG8_MMA(1, 0, At, B0); PG8_BAR; PG8_SCHED;
            PG8_STAGE(PG8_SB(0, 1), b2 + hstep, voffB);
            PG8_WAIT_V(6); PG8_BAR; PG8_MMA(1, 1, At, B1); PG8_BAR;
            PG8_LDB(B0, 1, 0); PG8_SCHED; PG8_LDA(At, 1, 0); PG8_STAGE(PG8_SA(0, 1), a2 + hstepA, voffA);
            PG8_WAIT_L(8); PG8_BAR; PG8_WAIT_L(0); PG8_MMA(0, 0, At, B0); PG8_BAR; PG8_SCHED;
            PG8_LDB(B1, 1, 1); PG8_STAGE(PG8_SB(1, 0), b3, voffB);
            PG8_BAR; PG8_WAIT_L(0); PG8_MMA(0, 1, At, B1); PG8_BAR;
            PG8_LDA(At, 1, 1); PG8_STAGE(PG8_SA(1, 0), a3, voffA);
            PG8_BAR; PG8_WAIT_L(0); PG8_MMA(1, 0, At, B0); PG8_BAR; PG8_SCHED;
            PG8_STAGE(PG8_SB(1, 1), b3 + hstep, voffB);
            PG8_WAIT_V(6); PG8_BAR; PG8_MMA(1, 1, At, B1); PG8_BAR;
            }
        }
        if constexpr (ALIGN_EPI) { if (wr == 0) PG8_BAR; }
        if constexpr (!Epi::AFTER_DRAIN) { E(acc, cur, wr, wc, fr, fq); S.done(cur); }
        if (!has_next) break;
#pragma unroll
        for (int a = 0; a < 2; ++a)
#pragma unroll
            for (int b = 0; b < 2; ++b)
#pragma unroll
                for (int m = 0; m < 4; ++m)
#pragma unroll
                    for (int n = 0; n < 2; ++n) acc[a][b][m][n] = (f32x4){0.f, 0.f, 0.f, 0.f};
        cur = nxt; cA = nA; cB = nB; ++ui;
        if constexpr (ALIGN_EPI) { if (wr == 1) PG8_BAR; }
    }
    PG8_WAIT_V(0);
    if constexpr (!ALIGN_EPI) { if (wr == 0) PG8_BAR; }
    PG8_BAR;
    if constexpr (Epi::AFTER_DRAIN) { E.fused(acc, cur, wr, wc, fr, fq, lds, wid, lane); S.done(cur); }
#undef PG8_SA
#undef PG8_SB
#undef PG8_STAGE
#undef PG8_LDA
#undef PG8_LDB
#undef PG8_MMA
#undef PG8_WAIT_V
#undef PG8_WAIT_L
#undef PG8_BAR
#undef PG8_SCHED
}
}

#define LAS __attribute__((address_space(3)))
#define DI __device__ __forceinline__
typedef unsigned short bf16_t;
typedef short bf16x8 __attribute__((ext_vector_type(8)));
typedef short s16x4 __attribute__((ext_vector_type(4)));
typedef float f32x4 __attribute__((ext_vector_type(4)));
typedef float f32x2 __attribute__((ext_vector_type(2)));
typedef float f32x16 __attribute__((ext_vector_type(16)));
typedef unsigned u32x4 __attribute__((ext_vector_type(4)));
typedef unsigned u32x2 __attribute__((ext_vector_type(2)));
using pg8::pk2;

constexpr int NWAVES = 8, NTHREADS = 512;
constexpr int DM = 1024, FF = 4096, NPR = 4096, NTOK = 12288, NROWC = 13312;
constexpr float EPS = 1e-6f, LOG2E = 1.4426950408889634f;
constexpr int LDS_BYTES = 147456;
constexpr size_t MiB = 1u << 20;
constexpr size_t WS_MOD = 1 * MiB;
constexpr size_t WS_WIN0 = 2 * MiB, WS_WQUP = 4 * MiB, WS_WKVUP = 4 * MiB + 512 * 1024, WS_WPOOL = 5 * MiB, WS_WOUT0 = 6 * MiB;
constexpr size_t WS_W1_0 = 8 * MiB, WS_W2_0 = 16 * MiB, WS_W1_1 = 24 * MiB, WS_W2_1 = 32 * MiB, WS_WIN1 = 40 * MiB, WS_WOUT1 = 46 * MiB;
constexpr size_t WS_H = 48 * MiB, WS_CAT = 72 * MiB, WS_Y0 = 96 * MiB, WS_QRAW = 96 * MiB, WS_KVRAW = 114 * MiB;
constexpr size_t WS_POOLED = 144 * MiB, WS_QN = 156 * MiB, WS_CKVB = 162 * MiB, WS_KROPE = 166 * MiB, WS_QF = 168 * MiB, WS_KF = 186 * MiB, WS_VF = 206 * MiB;
constexpr size_t WS_CK1 = 220 * MiB, WS_CV1 = 222 * MiB, WS_U = 96 * MiB;
constexpr size_t WS_ROWP = 224 * MiB, WS_SHW1 = 225 * MiB, WS_SHWIN = 225 * MiB + 128 * 1024;
constexpr size_t WS_Q1 = 96 * MiB, WS_K1 = 120 * MiB, WS_V1 = 144 * MiB;
constexpr size_t OUT_CKV = 12582912, OUT_KROPE = 13107200, OUT_NAK = 13238272, OUT_NAV = 17432576;

struct Args {
    const float* in[35];
    float* out; unsigned char* ws;
    int ph_lo, ph_hi;
};

struct Ctx {
    LAS unsigned char* lds;
    int tid, lane, wave, G;
};

typedef const __attribute__((address_space(4))) Args* ArgsP;
DI ArgsP get_args() { ArgsP p = (ArgsP)__builtin_amdgcn_kernarg_segment_ptr(); asm volatile("" : "+s"(p)); return p; }

DI float wave_sum(float v) {
    v = pg8::dpp_rmadd(pg8::dpp_hmadd(pg8::dpp_xadd2(pg8::dpp_xadd1(v)))); v = pg8::xadd32(pg8::xadd16(v));
    return v;
}
#define LDS_WAIT() asm volatile("s_waitcnt lgkmcnt(0)" ::: "memory")

#define XB_TMO      128
#define XB_XCNT(j)  (256  + 64 * (j))
#define XB_XSUB(j)  (1280 + 64 * (j))
#define XB_XGEN(j)  (2304 + 64 * (j))
#define XB_TOP      3328
#define XB_TOPGEN   3392
#define XCD_BAR_WORDS 3456
#define XB_SPIN_CAP (1u << 18)

__device__ __forceinline__ unsigned xb_ld(unsigned* p)              { return __hip_atomic_load(p, __ATOMIC_RELAXED, __HIP_MEMORY_SCOPE_AGENT); }
__device__ __forceinline__ unsigned xb_add(unsigned* p, unsigned v) { return __hip_atomic_fetch_add(p, v, __ATOMIC_RELAXED, __HIP_MEMORY_SCOPE_AGENT); }
__device__ __forceinline__ unsigned xb_xcc_id() { return (unsigned)__builtin_amdgcn_s_getreg((3 << 11) | 20) & 0xFu; }
#define XB_SPIN(cond, bar) do { unsigned _sp = 0; while (cond) { __builtin_amdgcn_s_sleep(1); \
    if ((++_sp & 255u) == 0u) { if (xb_ld(&(bar)[XB_TMO])) break; if (_sp > XB_SPIN_CAP) { atomicAdd(&(bar)[XB_TMO], 1u); break; } } } } while (0)

struct XcdBarrier {
    unsigned* bar; unsigned x;
    volatile LAS unsigned* st;
};

__device__ __forceinline__ XcdBarrier xcd_barrier_post(unsigned* bar, volatile LAS unsigned* st) {
    XcdBarrier b; b.bar = bar; b.x = xb_xcc_id(); b.st = st;
    if (threadIdx.x == 0) (void)xb_add(&bar[XB_XCNT(b.x)], 1u);
    return b;
}
__device__ __forceinline__ void xcd_barrier_complete(unsigned* bar, unsigned x, unsigned& nloc, unsigned& nx) {
    const unsigned G = gridDim.x * gridDim.y * gridDim.z;
    unsigned sum, cnt, mine, sp = 0u;
    for (;;) {
        sum = 0u; cnt = 0u; mine = 0u;
#pragma unroll
        for (unsigned j = 0; j < 16; ++j) { const unsigned c = xb_ld(&bar[XB_XCNT(j)]); sum += c; cnt += (c > 0u) ? 1u : 0u; mine = (j == x) ? c : mine; }
        if (sum == G) break;
        __builtin_amdgcn_s_sleep(1);
        if ((++sp & 255u) == 0u) { if (xb_ld(&bar[XB_TMO])) break; if (sp > XB_SPIN_CAP) { atomicAdd(&bar[XB_TMO], 1u); break; } }
    }
    nloc = mine > 0u ? mine : 1u; nx = cnt > 0u ? cnt : 1u;
}

__device__ __forceinline__ void xcd_barrier(const XcdBarrier& b) {
    asm volatile("s_waitcnt vmcnt(0)" ::: "memory");
    __syncthreads();
    if (threadIdx.x == 0) {
        unsigned* bar = b.bar;
        __builtin_amdgcn_s_waitcnt(0);
        unsigned nloc = b.st[0], nx = b.st[1];
        if (nloc == 0u) { xcd_barrier_complete(bar, b.x, nloc, nx); b.st[0] = nloc; b.st[1] = nx; }
        const unsigned old = xb_add(&bar[XB_XSUB(b.x)], 1u);
        const unsigned gen = old / nloc;
        if (old + 1u == (gen + 1u) * nloc) {
            __builtin_amdgcn_fence(__ATOMIC_RELEASE, "agent");
            asm volatile("s_waitcnt vmcnt(0)" ::: "memory");
            const unsigned og = xb_add(&bar[XB_TOP], 1u);
            const unsigned tg = og / nx;
            if (og + 1u == (tg + 1u) * nx) xb_add(&bar[XB_TOPGEN], 1u);
            else XB_SPIN(xb_ld(&bar[XB_TOPGEN]) == tg, bar);
            __builtin_amdgcn_fence(__ATOMIC_ACQUIRE, "agent");
            xb_add(&bar[XB_XGEN(b.x)], 1u);
            asm volatile("s_waitcnt vmcnt(0)" ::: "memory");
        } else {
            XB_SPIN(xb_ld(&bar[XB_XGEN(b.x)]) == gen, bar);
            __builtin_amdgcn_fence(__ATOMIC_ACQUIRE, "agent");
            asm volatile("s_waitcnt vmcnt(0)" ::: "memory");
        }
    }
    __syncthreads();
}

DI void tr_item(const float* W, int ldw, int k0, int n0, bf16_t* WT, int ldt, int drow0, int dcol0, LAS float* scr, int lane, const float* rscale = nullptr) {
    { f32x4 v[8];
      const float* wp = W + (size_t)(k0 + (lane >> 3)) * ldw + n0 + 4 * (lane & 7);
#pragma unroll
      for (int i = 0; i < 8; ++i) v[i] = *(const f32x4*)(wp + (size_t)(8 * i) * ldw);
#pragma unroll
      for (int i = 0; i < 8; ++i) { LAS float* sp = scr + ((lane >> 3) + 8 * i) * 33 + 4 * (lane & 7); sp[0] = v[i][0]; sp[1] = v[i][1]; sp[2] = v[i][2]; sp[3] = v[i][3]; } }
    LDS_WAIT();
    const int c = lane & 7;
#pragma unroll
    for (int j = 0; j < 4; ++j) { const int n = (lane >> 3) + 8 * j; const LAS float* s = scr + (8 * c) * 33 + n;
        const float rs = rscale ? rscale[n] : 1.f;
        u32x4 o; o.x = pk2(s[0 * 33] * rs, s[1 * 33] * rs); o.y = pk2(s[2 * 33] * rs, s[3 * 33] * rs); o.z = pk2(s[4 * 33] * rs, s[5 * 33] * rs); o.w = pk2(s[6 * 33] * rs, s[7 * 33] * rs);
        *(u32x4*)(WT + (size_t)(drow0 + n) * ldt + dcol0 + 8 * c) = o; }
    LDS_WAIT();
}
template <bool PERMQKV> DI void tr_matrix_item(const float* W, int K, int N, bf16_t* WT, int item, LAS float* scr, int lane) {
    const int nblk = N / 32, kb = item / nblk, nb = item % nblk, n0 = nb * 32;
    int drow0 = n0;
    if (PERMQKV) { const int tile = n0 >> 8, loc = n0 & 255, wc = loc >> 6, bj = (loc >> 5) & 1; drow0 = tile * 256 + 128 * bj + 32 * wc; }
    tr_item(W, N, kb * 64, n0, WT, K, drow0, kb * 64, scr, lane);
}

DI void gemv3_core(const Ctx& C, const float* W, int N, int c0, LAS float* ldsf) {
    const int tid = C.tid, lane = C.lane, wave = C.wave, kq = tid >> 4, cl = tid & 15;
    f32x4 a0 = {0.f, 0.f, 0.f, 0.f}, a1 = a0, a2 = a0;
    const float* wp = W + (size_t)kq * N + c0 + 4 * cl;
#pragma unroll 8
    for (int i = 0; i < 32; ++i) { const f32x4 w = *(const f32x4*)(wp + (size_t)(32 * i) * N); const int k = kq + 32 * i;
        a0 += w * ldsf[k]; a1 += w * ldsf[1024 + k]; a2 += w * ldsf[2048 + k]; }
#pragma unroll
    for (int e = 0; e < 4; ++e) { a0[e] = pg8::xadd32(pg8::xadd16(a0[e])); a1[e] = pg8::xadd32(pg8::xadd16(a1[e])); a2[e] = pg8::xadd32(pg8::xadd16(a2[e])); }
    LAS float* part = ldsf + 3072 + 192;
    if (lane < 16) { *(LAS f32x4*)(part + (wave * 3 + 0) * 64 + 4 * cl) = a0; *(LAS f32x4*)(part + (wave * 3 + 1) * 64 + 4 * cl) = a1; *(LAS f32x4*)(part + (wave * 3 + 2) * 64 + 4 * cl) = a2; }
    __syncthreads();
    if (tid < 192) { float s = 0.f;
#pragma unroll
        for (int w = 0; w < 8; ++w) s += part[w * 192 + tid];
        ldsf[3072 + tid] = s; }
    __syncthreads();
}

DI void phase_prologue(const Ctx& C, ArgsP A) {
    LAS float* ldsf = (LAS float*)C.lds;
    const int tid = C.tid, lane = C.lane, wave = C.wave;
    float* MOD = (float*)(A->ws + WS_MOD);
    if (P0_PARTS & 1)
    for (int u = blockIdx.x; u < 192; u += C.G) {
        const int layer = u / 96, c0 = (u % 96) * 64;
        const float* W = layer ? A->in[24] : A->in[8]; const float* bias = layer ? A->in[25] : A->in[9];
        __syncthreads();
        for (int i = tid; i < 3072; i += NTHREADS) { const int m = i >> 10, k = i & 1023; const float v = (m == 0) ? A->in[7][k] : A->in[6][(m - 1) * 1024 + k]; ldsf[i] = v / (1.f + expf(-v)); }
        __syncthreads();
        gemv3_core(C, W, 6144, c0, ldsf);
        if (tid < 192) { const int m = tid >> 6, l = tid & 63;
            MOD[(size_t)(layer * 3 + m) * 6144 + c0 + l] = ldsf[3072 + tid] + bias[c0 + l]; }
    }
    __syncthreads();
    {
        LAS float* scr = (LAS float*)(C.lds + wave * 16384);
        const int gw = blockIdx.x * NWAVES + wave, NGW = C.G * NWAVES;
        bf16_t* WIN0 = (bf16_t*)(A->ws + WS_WIN0); bf16_t* WQUP = (bf16_t*)(A->ws + WS_WQUP); bf16_t* WKVUP = (bf16_t*)(A->ws + WS_WKVUP); bf16_t* WPOOL = (bf16_t*)(A->ws + WS_WPOOL);
        bf16_t* WOUT0 = (bf16_t*)(A->ws + WS_WOUT0); bf16_t* W1_0 = (bf16_t*)(A->ws + WS_W1_0); bf16_t* W2_0 = (bf16_t*)(A->ws + WS_W2_0); bf16_t* W1_1 = (bf16_t*)(A->ws + WS_W1_1);
        bf16_t* W2_1 = (bf16_t*)(A->ws + WS_W2_1); bf16_t* WIN1 = (bf16_t*)(A->ws + WS_WIN1); bf16_t* WOUT1 = (bf16_t*)(A->ws + WS_WOUT1);
        constexpr int I_IN0 = 16 * 29, I_QUP = 4 * 24, I_KVUP = 2 * 32, I_POOL = 32, I_OUT = 16 * 32;
        constexpr int NITEMS = I_IN0 + I_QUP + I_KVUP + I_POOL + I_OUT;
        if (P0_PARTS & 2)
        for (int it = gw; it < NITEMS; it += NGW) {
            int r = it;
            if (r < I_IN0) { const int kb = r / 29, nb = r % 29; tr_item(A->in[14], 928, kb * 64, nb * 32, WIN0, 1024, nb * 32, kb * 64, scr, lane); continue; } r -= I_IN0;
            if (r < I_QUP) { tr_matrix_item<false>(A->in[17], 256, 768, WQUP, r, scr, lane); continue; } r -= I_QUP;
            if (r < I_KVUP) { tr_matrix_item<false>(A->in[18], 128, 1024, WKVUP, r, scr, lane); continue; } r -= I_KVUP;
            if (r < I_POOL) { const int g = r >> 3, kb = (r >> 2) & 1, nb = r & 3; tr_item(A->in[21] + (size_t)g * 128 * 128, 128, kb * 64, nb * 32, WPOOL, 512, g * 128 + nb * 32, g * 128 + kb * 64, scr, lane, A->in[22] + g * 128 + nb * 32); continue; }
            r -= I_POOL;
            tr_matrix_item<false>(A->in[23], 1024, 1024, WOUT0, r, scr, lane);
        }
        const int gt = blockIdx.x * NTHREADS + tid, NGT = C.G * NTHREADS;
        const u32x4 z = {0u, 0u, 0u, 0u};
        if (P0_PARTS & 4) {
        for (int c = gt; c < 96 * 128; c += NGT) *(u32x4*)(WIN0 + (size_t)928 * 1024 + (size_t)c * 8) = z;
        for (int c = gt; c < 512 * 64; c += NGT) { const int row = c >> 6, col0 = (c & 63) * 8; if ((row >> 7) != (col0 >> 7)) *(u32x4*)(WPOOL + (size_t)row * 512 + col0) = z; }
        if (gt < 128) ((float*)(A->ws + WS_MOD + 256 * 1024))[gt] = gt < 64 ? A->in[31][gt] : A->in[32][gt - 64];
        bf16_t* CKVB = (bf16_t*)(A->ws + WS_CKVB); float* KROPE = (float*)(A->ws + WS_KROPE); bf16_t* CK1 = (bf16_t*)(A->ws + WS_CK1); bf16_t* CV1 = (bf16_t*)(A->ws + WS_CV1);
        for (int c = gt; c < 1024 * 128 / 4; c += NGT) { const f32x4 v = *(const f32x4*)(A->in[2] + (size_t)c * 4); u32x2 o; o.x = pk2(v[0], v[1]); o.y = pk2(v[2], v[3]); *(u32x2*)(CKVB + (size_t)NTOK * 128 + (size_t)c * 4) = o; }
        for (int c = gt; c < 1024 * 32 / 4; c += NGT) *(f32x4*)(KROPE + (size_t)NTOK * 32 + (size_t)c * 4) = *(const f32x4*)(A->in[3] + (size_t)c * 4);
        for (int c = gt; c < 1024 * 1024 / 4; c += NGT) {
            const f32x4 v = *(const f32x4*)(A->in[4] + (size_t)c * 4); u32x2 o; o.x = pk2(v[0], v[1]); o.y = pk2(v[2], v[3]); *(u32x2*)(CK1 + (size_t)c * 4) = o;
            const f32x4 w = *(const f32x4*)(A->in[5] + (size_t)c * 4); u32x2 p; p.x = pk2(w[0], w[1]); p.y = pk2(w[2], w[3]); *(u32x2*)(CV1 + (size_t)c * 4) = p; }
        }
    }
}

template <int SET> DI void deferred_transposes(const Ctx& C, ArgsP A, int first) {
    const int nb = C.G - first, me = (int)blockIdx.x - first;
    if (me < 0) return;
    LAS float* scr = (LAS float*)(C.lds + C.wave * 16384);
    const int gw = me * NWAVES + C.wave, NGW = nb * NWAVES, lane = C.lane;
    constexpr int I_M1 = 16 * 128, I_M2 = 64 * 32, I_IN1 = 16 * 96, I_OUT = 16 * 32;
    if (SET == 0) { bf16_t* W1_0 = (bf16_t*)(A->ws + WS_W1_0); for (int it = gw; it < I_M1; it += NGW) tr_matrix_item<false>(A->in[12], 1024, 4096, W1_0, it, scr, lane); }
    if (SET == 1) { bf16_t* W2_0 = (bf16_t*)(A->ws + WS_W2_0); for (int it = gw; it < I_M2; it += NGW) tr_matrix_item<false>(A->in[13], 4096, 1024, W2_0, it, scr, lane); }
    if (SET == 2) {
        bf16_t* W1_1 = (bf16_t*)(A->ws + WS_W1_1); bf16_t* W2_1 = (bf16_t*)(A->ws + WS_W2_1); bf16_t* WIN1 = (bf16_t*)(A->ws + WS_WIN1); bf16_t* WOUT1 = (bf16_t*)(A->ws + WS_WOUT1);
        for (int it = gw; it < I_M1 + I_M2 + I_IN1 + I_OUT; it += NGW) {
            int r = it;
            if (r < I_M1) { tr_matrix_item<false>(A->in[28], 1024, 4096, W1_1, r, scr, lane); continue; } r -= I_M1;
            if (r < I_M2) { tr_matrix_item<false>(A->in[29], 4096, 1024, W2_1, r, scr, lane); continue; } r -= I_M2;
            if (r < I_IN1) { tr_matrix_item<true>(A->in[30], 1024, 3072, WIN1, r, scr, lane); continue; } r -= I_IN1;
            tr_matrix_item<false>(A->in[34], 1024, 1024, WOUT1, r, scr, lane);
        }
    }
}

template <bool PERMQKV> DI void gemv_sh_unit(const Ctx& C, const float* W, int N, const float* shvec  , float* outv  , int unit) {
    LAS float* ldsf = (LAS float*)C.lds;
    const int tid = C.tid, lane = C.lane, wave = C.wave, c0 = unit * 64;
    __syncthreads();
    for (int i = tid; i < 3072; i += NTHREADS) ldsf[i] = shvec[(size_t)(i >> 10) * 6144 + (i & 1023)];
    __syncthreads();
    gemv3_core(C, W, N, c0, ldsf);
    if (tid < 192) { const int m = tid >> 6, l = tid & 63;
        int dc = c0 + l;
        if (PERMQKV) { const int tile = dc >> 8, loc = dc & 255; dc = tile * 256 + 128 * ((loc >> 5) & 1) + 32 * (loc >> 6) + (loc & 31); }
        outv[(size_t)m * N + dc] = ldsf[3072 + tid]; }
}

DI void phase_modulate(const Ctx& C, ArgsP A, const float* x0, const float* x1, const float* normw, const float* mod, int sh_off, int sc_off) {
    bf16_t* H = (bf16_t*)(A->ws + WS_H);
    const int gw = blockIdx.x * NWAVES + C.wave, NGW = C.G * NWAVES, lane = C.lane;
    for (int r = gw; r < NTOK; r += 2 * NGW) {
        const int rb = r + NGW; const bool two = rb < NTOK; const int r2 = two ? rb : r;
        const float* xa = (r < NPR) ? x0 + (size_t)r * DM : x1 + (size_t)(r - NPR) * DM;
        const float* xb = (r2 < NPR) ? x0 + (size_t)r2 * DM : x1 + (size_t)(r2 - NPR) * DM;
        f32x4 va[4], vb[4]; float sa = 0.f, sb = 0.f;
#pragma unroll
        for (int j = 0; j < 4; ++j) { va[j] = *(const f32x4*)(xa + 4 * (lane + 64 * j)); vb[j] = *(const f32x4*)(xb + 4 * (lane + 64 * j)); }
#pragma unroll
        for (int j = 0; j < 4; ++j) { sa += (va[j][0] * va[j][0] + va[j][1] * va[j][1]) + (va[j][2] * va[j][2] + va[j][3] * va[j][3]); sb += (vb[j][0] * vb[j][0] + vb[j][1] * vb[j][1]) + (vb[j][2] * vb[j][2] + vb[j][3] * vb[j][3]); }
        const float rsa = __builtin_amdgcn_rsqf(wave_sum(sa) * (1.f / DM) + EPS), rsb = __builtin_amdgcn_rsqf(wave_sum(sb) * (1.f / DM) + EPS);
        const float* ma = mod + (size_t)(r >> 12) * 6144; const float* mb = mod + (size_t)(r2 >> 12) * 6144;
#pragma unroll
        for (int j = 0; j < 4; ++j) { const int col = 4 * (lane + 64 * j);
            const f32x4 w = *(const f32x4*)(normw + col);
            { const f32x4 sc = *(const f32x4*)(ma + sc_off + col), sh = *(const f32x4*)(ma + sh_off + col); const f32x4 h = (va[j] * rsa * w) * (sc + 1.f) + sh;
              u32x2 o; o.x = pk2(h[0], h[1]); o.y = pk2(h[2], h[3]); *(u32x2*)(H + (size_t)r * DM + col) = o; }
            if (two) { const f32x4 sc = *(const f32x4*)(mb + sc_off + col), sh = *(const f32x4*)(mb + sh_off + col); const f32x4 h = (vb[j] * rsb * w) * (sc + 1.f) + sh;
              u32x2 o; o.x = pk2(h[0], h[1]); o.y = pk2(h[2], h[3]); *(u32x2*)(H + (size_t)r2 * DM + col) = o; } }
    }
}

DI void phase_post_in0(const Ctx& C, ArgsP A) {
    const float* Y0 = (const float*)(A->ws + WS_Y0);
    bf16_t* POOLED = (bf16_t*)(A->ws + WS_POOLED); bf16_t* QN = (bf16_t*)(A->ws + WS_QN); bf16_t* CKVB = (bf16_t*)(A->ws + WS_CKVB); float* KROPE = (float*)(A->ws + WS_KROPE);
    const float* qln = A->in[15]; const float* kvln = A->in[16];
    const int gw = blockIdx.x * NWAVES + C.wave, NGW = C.G * NWAVES, lane = C.lane;
    const f32x4 qw = *(const f32x4*)(qln + 4 * lane); const f32x2 kw = *(const f32x2*)(kvln + 2 * lane);
    for (int r = gw; r < NTOK; r += NGW) {
        const float* Y = Y0 + (size_t)r * 1024;
        int S, t; if (r < NPR) { S = 256; t = r & 255; } else { S = 4096; t = (r - NPR) & 4095; }
        const float* Yseq = Y0 + (size_t)(r - t) * 1024;
        const f32x4 q = *(const f32x4*)(Y + 512 + 4 * lane);
        const f32x2 k = *(const f32x2*)(Y + 768 + 2 * lane);
        const float kr = Y[896 + (lane & 31)];
        f32x2 ps[4], pa[4]; float pinv[4];
#pragma unroll
        for (int g = 0; g < 4; ++g) {
            const int win = 2 << g; int lo = t - win / 2, hi = lo + win; lo = lo < 0 ? 0 : lo; hi = hi > S ? S : hi;
            const int col = g * 128 + 2 * lane;
            f32x2 s2 = {0.f, 0.f};
#pragma unroll
            for (int kk = 0; kk < win; ++kk) { const int j = t - win / 2 + kk; const int jc = j < 0 ? 0 : (j >= S ? S - 1 : j);
                const f32x2 v = *(const f32x2*)(Yseq + (size_t)jc * 1024 + col); const float wgt = (j >= 0 && j < S) ? 1.f : 0.f; s2 += v * wgt; }
            ps[g] = s2; pa[g] = *(const f32x2*)(Y + col); pinv[g] = 1.f / (float)(hi - lo);
        }
        const float ssq = wave_sum((q[0] * q[0] + q[1] * q[1]) + (q[2] * q[2] + q[3] * q[3]));
        const float ssk = wave_sum(k[0] * k[0] + k[1] * k[1]);
#pragma unroll
        for (int g = 0; g < 4; ++g) *(unsigned*)(POOLED + (size_t)r * 512 + g * 128 + 2 * lane) = pk2(ps[g][0] * pinv[g] - pa[g][0], ps[g][1] * pinv[g] - pa[g][1]);
        { const float rstd = __builtin_amdgcn_rsqf(ssq * (1.f / 256.f) + EPS); const f32x4 o = q * rstd * qw;
          u32x2 p; p.x = pk2(o[0], o[1]); p.y = pk2(o[2], o[3]); *(u32x2*)(QN + (size_t)r * 256 + 4 * lane) = p; }
        { const float rstd = __builtin_amdgcn_rsqf(ssk * (1.f / 128.f) + EPS); const f32x2 o = k * rstd * kw;
          *(unsigned*)(CKVB + (size_t)r * 128 + 2 * lane) = pk2(o[0], o[1]);
          if (r < NPR) *(f32x2*)(A->out + OUT_CKV + (size_t)r * 128 + 2 * lane) = o; }
        if (lane < 32) { KROPE[(size_t)r * 32 + lane] = kr; if (r < NPR) A->out[OUT_KROPE + (size_t)r * 32 + lane] = kr; }
    }
}

DI float bf2f(bf16_t b) { return __uint_as_float((unsigned)b << 16); }
DI bf16_t f2bf1(float v) { return (bf16_t)(pk2(v, 0.f) & 0xffffu); }
DI void phase_mla_finish(const Ctx& C, ArgsP A) {
    const bf16_t* QRAW = (const bf16_t*)(A->ws + WS_QRAW); const bf16_t* KVRAW = (const bf16_t*)(A->ws + WS_KVRAW); const float* KROPE = (const float*)(A->ws + WS_KROPE);
    bf16_t* QF = (bf16_t*)(A->ws + WS_QF); bf16_t* KF = (bf16_t*)(A->ws + WS_KF); bf16_t* VF = (bf16_t*)(A->ws + WS_VF);
    const float* qnw = A->in[19]; const float* knw = A->in[20];
    const int tid = C.tid, lane = C.lane, wave = C.wave;
    LAS float* tab = (LAS float*)(C.lds + 65536);
    LAS float* qs = (LAS float*)(C.lds + wave * 8192);
    __syncthreads();
    for (int i = tid; i < 512; i += NTHREADS) { const int pos = i >> 3, f = i & 7; const float ang = (float)pos * exp2f(-(float)f * (13.287712379549449f / 8.f)); tab[2 * i] = cosf(ang); tab[2 * i + 1] = sinf(ang); }
    __syncthreads();
    const float QSC = 0.10206207261596577f * LOG2E;
    const int gw = blockIdx.x * NWAVES + wave, NGW = C.G * NWAVES;
    const int hh = lane >> 3, d0 = 12 * (lane & 7);
    for (int r = gw; r < NROWC; r += NGW) {
        const bool is_tok = r < NTOK, latent = (r >= NPR) && is_tok;
        const int t = (r - NPR) & 4095, prow = t >> 6, pcol = t & 63;
        size_t dst;
        if (r < NPR) dst = r; else if (is_tok) dst = (size_t)NPR + (size_t)((r - NPR) >> 12) * 4608 + t; else { const int i = r - NTOK; dst = (size_t)NPR + (size_t)(i >> 9) * 4608 + 4096 + (i & 511); }
        const int l8 = lane & 7;
        const u32x4 kn = *(const u32x4*)(KVRAW + (size_t)r * 1024 + hh * 128 + 8 * l8); const f32x4 krp = *(const f32x4*)(KROPE + (size_t)r * 32 + 4 * l8);
        const u32x4 vv = *(const u32x4*)(KVRAW + (size_t)r * 1024 + hh * 128 + 64 + 8 * l8);
        if (is_tok) {
            float x[12]; float ss = 0.f;
            const s16x4* qp = (const s16x4*)(QRAW + (size_t)r * 768 + 12 * lane);
#pragma unroll
            for (int c = 0; c < 3; ++c) { const s16x4 v = qp[c];
#pragma unroll
                for (int e = 0; e < 4; ++e) { x[4 * c + e] = bf2f((bf16_t)v[e]); ss += x[4 * c + e] * x[4 * c + e]; } }
            ss = pg8::dpp_hmadd(pg8::dpp_xadd2(pg8::dpp_xadd1(ss)));
            const float rstd = __builtin_amdgcn_rsqf(ss * (1.f / 96.f) + EPS);
#pragma unroll
            for (int i = 0; i < 12; ++i) qs[12 * lane + i] = x[i] * rstd * qnw[d0 + i];
            LDS_WAIT();
#pragma unroll
            for (int i = 0; i < 12; ++i) { const int e = lane + 64 * i, d = e % 96; const float v0 = qs[e];
                const int j = (d - 64) & 31, jj = j & 15, f = jj & 7, pos = (j >> 4) ? pcol : prow; const bool lo = jj < 8; const int pe = lo ? e + 8 : (e >= 8 ? e - 8 : 0);
                const float pv = qs[pe], cs = tab[2 * (pos * 8 + f)], sn = tab[2 * (pos * 8 + f) + 1];
                const float rot = lo ? v0 * cs - pv * sn : pv * sn + v0 * cs; const float v = (latent && d >= 64) ? rot : v0;
                QF[(size_t)r * 768 + e] = f2bf1(v * QSC); }
            LDS_WAIT();
        }
        {
            float x[12]; float ss = 0.f; const f32x4 kr = krp;
#pragma unroll
            for (int c = 0; c < 4; ++c) { x[2 * c] = __uint_as_float(kn[c] << 16); x[2 * c + 1] = __uint_as_float(kn[c] & 0xffff0000u); x[8 + c] = kr[c]; }
#pragma unroll
            for (int i = 0; i < 12; ++i) ss += x[i] * x[i];
            ss = pg8::dpp_hmadd(pg8::dpp_xadd2(pg8::dpp_xadd1(ss)));
            const float rstd = __builtin_amdgcn_rsqf(ss * (1.f / 96.f) + EPS);
#pragma unroll
            for (int i = 0; i < 8; ++i) qs[hh * 96 + 8 * l8 + i] = x[i] * rstd * knw[8 * l8 + i];
#pragma unroll
            for (int i = 0; i < 4; ++i) qs[hh * 96 + 64 + 4 * l8 + i] = x[8 + i] * rstd * knw[64 + 4 * l8 + i];
            LDS_WAIT();
#pragma unroll
            for (int i = 0; i < 12; ++i) { const int e = lane + 64 * i, d = e % 96; const float v0 = qs[e];
                const int j = (d - 64) & 31, jj = j & 15, f = jj & 7, pos = (j >> 4) ? pcol : prow; const bool lo = jj < 8; const int pe = lo ? e + 8 : (e >= 8 ? e - 8 : 0);
                const float pv = qs[pe], cs = tab[2 * (pos * 8 + f)], sn = tab[2 * (pos * 8 + f) + 1];
                const float rot = lo ? v0 * cs - pv * sn : pv * sn + v0 * cs; const float v = (latent && d >= 64) ? rot : v0;
                KF[dst * 768 + e] = f2bf1(v); }
            LDS_WAIT();
        }
        *(u32x4*)(VF + dst * 512 + hh * 64 + 8 * l8) = vv;
    }
}

DI float max3f(float a, float b, float c) { float r; asm("v_max3_f32 %0, %1, %2, %3" : "=v"(r) : "v"(a), "v"(b), "v"(c)); return r; }
constexpr int ATT_K_OFF = 0, ATT_V_OFF = 13312, ATT_VRS = 192  , ATT_BUF = 13312 + 64 * ATT_VRS, ATT_B_OFF = 122880;
static_assert(2 * ATT_BUF <= 69632 && 69632 <= ATT_B_OFF, "attention LDS map");
DI void softmax_step(f32x16& s, float& m, float& l, f32x16& oa, f32x16& ob) {
    const float x0 = max3f(s[0], s[1], s[2]), x1 = max3f(s[3], s[4], s[5]), x2 = max3f(s[6], s[7], s[8]), x3 = max3f(s[9], s[10], s[11]), x4 = max3f(s[12], s[13], s[14]);
    float mxr = max3f(max3f(x0, x1, x2), max3f(x3, x4, s[15]), -1e30f);
    if (__builtin_amdgcn_ballot_w64(mxr > 8.f) != 0ull) {
        mxr = pg8::xmax32(mxr);
        const float delta = fmaxf(mxr, 0.f), alpha = __builtin_amdgcn_exp2f(-delta);
        m += delta; s = s - delta; l *= alpha; oa = oa * alpha; ob = ob * alpha;
    }
#pragma unroll
    for (int i = 0; i < 16; ++i) s[i] = __builtin_amdgcn_exp2f(s[i]);
    l += (((s[0] + s[1]) + (s[2] + s[3])) + ((s[4] + s[5]) + (s[6] + s[7]))) + (((s[8] + s[9]) + (s[10] + s[11])) + ((s[12] + s[13]) + (s[14] + s[15])));
}
DI bf16x8 pack8(const f32x16& s, int jj) {
    u32x4 pw; pw.x = pk2(s[8 * jj + 0], s[8 * jj + 1]); pw.y = pk2(s[8 * jj + 2], s[8 * jj + 3]); pw.z = pk2(s[8 * jj + 4], s[8 * jj + 5]); pw.w = pk2(s[8 * jj + 6], s[8 * jj + 7]);
    return __builtin_bit_cast(bf16x8, pw);
}
template <int DQ, int MODE, int qstride, int kstride, int vstride, int ostride>
DI void attn_unit(LAS unsigned char* lds, const bf16_t* Q,
                  const bf16_t* K0, const bf16_t* V0, int n0, const bf16_t* K1p, const bf16_t* V1p, int nT,
                  bf16_t* O, int kr_lo, int r0) {
    const int tid = threadIdx.x, lane = tid & 63, wave = tid >> 6, r32 = lane & 31, hi = lane >> 5, pg = wave >> 1, ksub = wave & 1;
    constexpr int KS = DQ + 8, NKC = DQ / 8, NS = DQ / 16;
    const LAS float* Bl = (const LAS float*)(lds + ATT_B_OFF);
    bf16x8 qf[2][NS];
#pragma unroll
    for (int qg = 0; qg < 2; ++qg) { const bf16_t* qp = Q + (size_t)(pg * 64 + qg * 32 + r32) * qstride + 8 * hi;
#pragma unroll
      for (int s = 0; s < NS; ++s) qf[qg][s] = *(const bf16x8*)(qp + 16 * s); }
    f32x16 o[2][2];
#pragma unroll
    for (int i = 0; i < 16; ++i) { o[0][0][i] = 0.f; o[0][1][i] = 0.f; o[1][0][i] = 0.f; o[1][1][i] = 0.f; }
    float m[2] = {0.f, 0.f}, l[2] = {0.f, 0.f};
    const int kc0 = tid, krow0 = kc0 / NKC, kcc0 = kc0 % NKC;
    const int kc1 = tid + 512, krow1 = kc1 / NKC, kcc1 = kc1 % NKC;
    const bool k2 = (DQ == 96) && (tid < 256);
    const int vkey = tid >> 3, vdc = tid & 7;
    u32x4 kA0, kA1 = {0u, 0u, 0u, 0u}, vA, kB0 = {0u, 0u, 0u, 0u}, kB1 = {0u, 0u, 0u, 0u}, vB = {0u, 0u, 0u, 0u};
    const int qr = r0 + pg, rs = qr - 4 < 0 ? 0 : (qr - 4 > 56 ? 56 : qr - 4);
    const unsigned vtr_off = (unsigned)((32 * ksub + 4 * hi + ((lane & 15) >> 2)) * ATT_VRS + (16 * ((lane >> 4) & 1) + 4 * (lane & 3)) * 2);
#define ATT_WRITE(b, K0_, K1_, V_) do { LAS bf16_t* Kw = (LAS bf16_t*)(lds + (b) * ATT_BUF + ATT_K_OFF); LAS unsigned char* Vw = lds + (b) * ATT_BUF + ATT_V_OFF; \
        *(LAS u32x4*)(Kw + krow0 * KS + kcc0 * 8) = K0_; if (k2) *(LAS u32x4*)(Kw + krow1 * KS + kcc1 * 8) = K1_; \
        *(LAS u32x4*)(Vw + vkey * ATT_VRS + vdc * 16) = V_; } while (0)
#define ATT_LOAD(tn_, K0_, K1_, V_) do { const int tn = (tn_); const bf16_t* kt = (tn < n0) ? K0 + (size_t)tn * 64 * kstride : K1p + (size_t)(tn - n0) * 64 * kstride; const bf16_t* vt = (tn < n0) ? V0 + (size_t)tn * 64 * vstride : V1p + (size_t)(tn - n0) * 64 * vstride; \
        K0_ = *(const u32x4*)(kt + (size_t)krow0 * kstride + kcc0 * 8); if (k2) K1_ = *(const u32x4*)(kt + (size_t)krow1 * kstride + kcc1 * 8); \
        V_ = *(const u32x4*)(vt + (size_t)vkey * vstride + vdc * 8); } while (0)
    if constexpr (DQ == 96) {
    ATT_LOAD(0, kA0, kA1, vA);
    __syncthreads();
    ATT_WRITE(0, kA0, kA1, vA);
    if (nT > 1) ATT_LOAD(1, kA0, kA1, vA);
    __syncthreads();
    for (int t = 0; t < nT; ++t) {
        const LAS bf16_t* Kl = (const LAS bf16_t*)(lds + (t & 1) * ATT_BUF + ATT_K_OFF);
        bool local = false, skip = false; int krow = 0;
        if (MODE == 1) { local = t < n0; krow = kr_lo + t; skip = local && (krow < rs || krow >= rs + 8); }
        if (!skip) {
        f32x16 sc[2];
#pragma unroll
        for (int i = 0; i < 16; ++i) { sc[0][i] = -m[0]; sc[1][i] = -m[1]; }
        bf16x8 kf[NS];
#pragma unroll
        for (int st = 0; st < NS; ++st) kf[st] = *(const LAS bf16x8*)(Kl + (32 * ksub + r32) * KS + 16 * st + 8 * hi);
        __builtin_amdgcn_sched_barrier(0);
        __builtin_amdgcn_s_setprio(1);
#pragma unroll
        for (int st = 0; st < NS; ++st) sc[0] = __builtin_amdgcn_mfma_f32_32x32x16_bf16(kf[st], qf[0][st], sc[0], 0, 0, 0);
#pragma unroll
        for (int st = 0; st < NS; ++st) sc[1] = __builtin_amdgcn_mfma_f32_32x32x16_bf16(kf[st], qf[1][st], sc[1], 0, 0, 0);
        __builtin_amdgcn_s_setprio(0);
        __builtin_amdgcn_sched_barrier(0);
        u32x2 vt0, vt1, vt2, vt3, vt4, vt5, vt6, vt7;
        { const unsigned va = (unsigned)(size_t)(lds + (t & 1) * ATT_BUF + ATT_V_OFF) + vtr_off;
          asm volatile("ds_read_b64_tr_b16 %0, %8\n\tds_read_b64_tr_b16 %1, %8 offset:1536\n\tds_read_b64_tr_b16 %2, %8 offset:3072\n\tds_read_b64_tr_b16 %3, %8 offset:4608\n\t"
                       "ds_read_b64_tr_b16 %4, %8 offset:64\n\tds_read_b64_tr_b16 %5, %8 offset:1600\n\tds_read_b64_tr_b16 %6, %8 offset:3136\n\tds_read_b64_tr_b16 %7, %8 offset:4672"
                       : "=&v"(vt0), "=&v"(vt1), "=&v"(vt2), "=&v"(vt3), "=&v"(vt4), "=&v"(vt5), "=&v"(vt6), "=&v"(vt7) : "v"(va) : "memory"); }
        __builtin_amdgcn_sched_barrier(0);
#define NA_MASK(QG) do { if (MODE == 1) { if (local) { const LAS float* brow = Bl + (krow - qr + 7) * 32; \
            const int qc = 32 * (QG) + r32, cs0 = qc - 8 < 0 ? 0 : (qc - 8 > 48 ? 48 : qc - 8); \
            const int d0 = 32 * ksub + 4 * hi - cs0; const LAS float* bp = brow + (32 * ksub + 4 * hi - qc + 15); float bvv[16]; \
            _Pragma("unroll") for (int i = 0; i < 16; ++i) bvv[i] = bp[8 * (i >> 2) + (i & 3)]; \
            asm volatile("" : "+v"(bvv[0]), "+v"(bvv[1]), "+v"(bvv[2]), "+v"(bvv[3]), "+v"(bvv[4]), "+v"(bvv[5]), "+v"(bvv[6]), "+v"(bvv[7]), "+v"(bvv[8]), "+v"(bvv[9]), "+v"(bvv[10]), "+v"(bvv[11]), "+v"(bvv[12]), "+v"(bvv[13]), "+v"(bvv[14]), "+v"(bvv[15])); \
            _Pragma("unroll") for (int i = 0; i < 16; ++i) { const int c = 8 * (i >> 2) + (i & 3); sc[QG][i] = ((unsigned)(d0 + c) < 16u) ? sc[QG][i] + bvv[i] : -1e30f; } } } } while (0)
#define NA_SPARSE(QG, I0, PB) do { const LAS float* brow = Bl + (krow - qr + 7) * 32; \
            const int qc = 32 * (QG) + r32, cs0 = qc - 8 < 0 ? 0 : (qc - 8 > 48 ? 48 : qc - 8); \
            const int d0 = 32 * ksub + 4 * hi - cs0; const LAS float* bp = brow + (32 * ksub + 4 * hi - qc + 15); float e_[4]; \
            float b_[4]; _Pragma("unroll") for (int k_ = 0; k_ < 4; ++k_) { const int i_ = (I0) + k_; b_[k_] = bp[8 * (i_ >> 2) + (i_ & 3)]; } \
            asm volatile("" : "+v"(b_[0]), "+v"(b_[1]), "+v"(b_[2]), "+v"(b_[3])); \
            _Pragma("unroll") for (int k_ = 0; k_ < 4; ++k_) { const int i_ = (I0) + k_, c_ = 8 * (i_ >> 2) + (i_ & 3); e_[k_] = ((unsigned)(d0 + c_) < 16u) ? sc[QG][i_] + b_[k_] : -1e30f; } \
            float mx_ = fmaxf(max3f(e_[0], e_[1], e_[2]), e_[3]); \
            if (__builtin_amdgcn_ballot_w64(mx_ > 8.f) != 0ull) { mx_ = pg8::xmax32(mx_); const float dl_ = fmaxf(mx_, 0.f), al_ = __builtin_amdgcn_exp2f(-dl_); \
                m[QG] += dl_; l[QG] *= al_; o[QG][0] = o[QG][0] * al_; o[QG][1] = o[QG][1] * al_; _Pragma("unroll") for (int k_ = 0; k_ < 4; ++k_) e_[k_] -= dl_; } \
            _Pragma("unroll") for (int k_ = 0; k_ < 4; ++k_) e_[k_] = __builtin_amdgcn_exp2f(e_[k_]); \
            l[QG] += (e_[0] + e_[1]) + (e_[2] + e_[3]); \
            u32x4 pw_ = {0u, 0u, 0u, 0u}; if ((I0) == 0) { pw_.x = pk2(e_[0], e_[1]); pw_.y = pk2(e_[2], e_[3]); } else { pw_.z = pk2(e_[0], e_[1]); pw_.w = pk2(e_[2], e_[3]); } \
            PB = __builtin_bit_cast(bf16x8, pw_); } while (0)
        bool sp0 = false, sp1 = false;
        if (MODE == 1) { sp0 = local && (ksub == 1); sp1 = local && (ksub == 0); }
        bf16x8 p00, p01;
        if (sp0) { NA_SPARSE(0, 0, p00); p01 = p00; }
        else { NA_MASK(0); softmax_step(sc[0], m[0], l[0], o[0][0], o[0][1]); p00 = pack8(sc[0], 0); p01 = pack8(sc[0], 1); }
        asm volatile("s_waitcnt lgkmcnt(0)" : "+v"(vt0), "+v"(vt1), "+v"(vt2), "+v"(vt3), "+v"(vt4), "+v"(vt5), "+v"(vt6), "+v"(vt7) :: "memory");
        const u32x4 a00 = {vt0.x, vt0.y, vt1.x, vt1.y}, a01 = {vt2.x, vt2.y, vt3.x, vt3.y}, a10 = {vt4.x, vt4.y, vt5.x, vt5.y}, a11 = {vt6.x, vt6.y, vt7.x, vt7.y};
        __builtin_amdgcn_s_setprio(1);
        o[0][0] = __builtin_amdgcn_mfma_f32_32x32x16_bf16(__builtin_bit_cast(bf16x8, a00), p00, o[0][0], 0, 0, 0);
        o[0][1] = __builtin_amdgcn_mfma_f32_32x32x16_bf16(__builtin_bit_cast(bf16x8, a10), p00, o[0][1], 0, 0, 0);
        if (!sp0) {
          o[0][0] = __builtin_amdgcn_mfma_f32_32x32x16_bf16(__builtin_bit_cast(bf16x8, a01), p01, o[0][0], 0, 0, 0);
          o[0][1] = __builtin_amdgcn_mfma_f32_32x32x16_bf16(__builtin_bit_cast(bf16x8, a11), p01, o[0][1], 0, 0, 0); }
        __builtin_amdgcn_s_setprio(0);
        __builtin_amdgcn_sched_barrier(0);
        bf16x8 p10, p11;
        if (sp1) { NA_SPARSE(1, 12, p11); p10 = p11; }
        else { NA_MASK(1); softmax_step(sc[1], m[1], l[1], o[1][0], o[1][1]); p10 = pack8(sc[1], 0); p11 = pack8(sc[1], 1); }
        __builtin_amdgcn_s_setprio(1);
        o[1][0] = __builtin_amdgcn_mfma_f32_32x32x16_bf16(__builtin_bit_cast(bf16x8, a01), p11, o[1][0], 0, 0, 0);
        o[1][1] = __builtin_amdgcn_mfma_f32_32x32x16_bf16(__builtin_bit_cast(bf16x8, a11), p11, o[1][1], 0, 0, 0);
        if (!sp1) {
          o[1][0] = __builtin_amdgcn_mfma_f32_32x32x16_bf16(__builtin_bit_cast(bf16x8, a00), p10, o[1][0], 0, 0, 0);
          o[1][1] = __builtin_amdgcn_mfma_f32_32x32x16_bf16(__builtin_bit_cast(bf16x8, a10), p10, o[1][1], 0, 0, 0); }
        __builtin_amdgcn_s_setprio(0);
#undef NA_SPARSE
#undef NA_MASK
        }
        if (t + 1 < nT) { ATT_WRITE((t + 1) & 1, kA0, kA1, vA); if (t + 2 < nT) ATT_LOAD(t + 2, kA0, kA1, vA); }
        __syncthreads();
    }
    } else {
    ATT_LOAD(0, kA0, kA1, vA);
    if (nT > 1) ATT_LOAD(1, kB0, kB1, vB);
    __syncthreads();
    ATT_WRITE(0, kA0, kA1, vA);
    if (nT > 2) ATT_LOAD(2, kA0, kA1, vA);
    __syncthreads();
    for (int t0 = 0; t0 < nT; t0 += 2) {
        { const int t = t0;
        const LAS bf16_t* Kl = (const LAS bf16_t*)(lds + (t & 1) * ATT_BUF + ATT_K_OFF);
        bool local = false, skip = false; int krow = 0;
        if (MODE == 1) { local = t < n0; krow = kr_lo + t; skip = local && (krow < rs || krow >= rs + 8); }
        if (!skip) {
        f32x16 sc[2];
#pragma unroll
        for (int i = 0; i < 16; ++i) { sc[0][i] = -m[0]; sc[1][i] = -m[1]; }
        bf16x8 kf[NS];
#pragma unroll
        for (int st = 0; st < NS; ++st) kf[st] = *(const LAS bf16x8*)(Kl + (32 * ksub + r32) * KS + 16 * st + 8 * hi);
        __builtin_amdgcn_sched_barrier(0);
        __builtin_amdgcn_s_setprio(1);
#pragma unroll
        for (int st = 0; st < NS; ++st) sc[0] = __builtin_amdgcn_mfma_f32_32x32x16_bf16(kf[st], qf[0][st], sc[0], 0, 0, 0);
#pragma unroll
        for (int st = 0; st < NS; ++st) sc[1] = __builtin_amdgcn_mfma_f32_32x32x16_bf16(kf[st], qf[1][st], sc[1], 0, 0, 0);
        __builtin_amdgcn_s_setprio(0);
        __builtin_amdgcn_sched_barrier(0);
        u32x2 vt0, vt1, vt2, vt3, vt4, vt5, vt6, vt7;
        { const unsigned va = (unsigned)(size_t)(lds + (t & 1) * ATT_BUF + ATT_V_OFF) + vtr_off;
          asm volatile("ds_read_b64_tr_b16 %0, %8\n\tds_read_b64_tr_b16 %1, %8 offset:1536\n\tds_read_b64_tr_b16 %2, %8 offset:3072\n\tds_read_b64_tr_b16 %3, %8 offset:4608\n\t"
                       "ds_read_b64_tr_b16 %4, %8 offset:64\n\tds_read_b64_tr_b16 %5, %8 offset:1600\n\tds_read_b64_tr_b16 %6, %8 offset:3136\n\tds_read_b64_tr_b16 %7, %8 offset:4672"
                       : "=&v"(vt0), "=&v"(vt1), "=&v"(vt2), "=&v"(vt3), "=&v"(vt4), "=&v"(vt5), "=&v"(vt6), "=&v"(vt7) : "v"(va) : "memory"); }
        __builtin_amdgcn_sched_barrier(0);
#define NA_MASK(QG) do { if (MODE == 1) { if (local) { const LAS float* brow = Bl + (krow - qr + 7) * 32; \
            const int qc = 32 * (QG) + r32, cs0 = qc - 8 < 0 ? 0 : (qc - 8 > 48 ? 48 : qc - 8); \
            const int d0 = 32 * ksub + 4 * hi - cs0; const LAS float* bp = brow + (32 * ksub + 4 * hi - qc + 15); float bvv[16]; \
            _Pragma("unroll") for (int i = 0; i < 16; ++i) bvv[i] = bp[8 * (i >> 2) + (i & 3)]; \
            asm volatile("" : "+v"(bvv[0]), "+v"(bvv[1]), "+v"(bvv[2]), "+v"(bvv[3]), "+v"(bvv[4]), "+v"(bvv[5]), "+v"(bvv[6]), "+v"(bvv[7]), "+v"(bvv[8]), "+v"(bvv[9]), "+v"(bvv[10]), "+v"(bvv[11]), "+v"(bvv[12]), "+v"(bvv[13]), "+v"(bvv[14]), "+v"(bvv[15])); \
            _Pragma("unroll") for (int i = 0; i < 16; ++i) { const int c = 8 * (i >> 2) + (i & 3); sc[QG][i] = ((unsigned)(d0 + c) < 16u) ? sc[QG][i] + bvv[i] : -1e30f; } } } } while (0)
#define NA_SPARSE(QG, I0, PB) do { const LAS float* brow = Bl + (krow - qr + 7) * 32; \
            const int qc = 32 * (QG) + r32, cs0 = qc - 8 < 0 ? 0 : (qc - 8 > 48 ? 48 : qc - 8); \
            const int d0 = 32 * ksub + 4 * hi - cs0; const LAS float* bp = brow + (32 * ksub + 4 * hi - qc + 15); float e_[4]; \
            float b_[4]; _Pragma("unroll") for (int k_ = 0; k_ < 4; ++k_) { const int i_ = (I0) + k_; b_[k_] = bp[8 * (i_ >> 2) + (i_ & 3)]; } \
            asm volatile("" : "+v"(b_[0]), "+v"(b_[1]), "+v"(b_[2]), "+v"(b_[3])); \
            _Pragma("unroll") for (int k_ = 0; k_ < 4; ++k_) { const int i_ = (I0) + k_, c_ = 8 * (i_ >> 2) + (i_ & 3); e_[k_] = ((unsigned)(d0 + c_) < 16u) ? sc[QG][i_] + b_[k_] : -1e30f; } \
            float mx_ = fmaxf(max3f(e_[0], e_[1], e_[2]), e_[3]); \
            if (__builtin_amdgcn_ballot_w64(mx_ > 8.f) != 0ull) { mx_ = pg8::xmax32(mx_); const float dl_ = fmaxf(mx_, 0.f), al_ = __builtin_amdgcn_exp2f(-dl_); \
                m[QG] += dl_; l[QG] *= al_; o[QG][0] = o[QG][0] * al_; o[QG][1] = o[QG][1] * al_; _Pragma("unroll") for (int k_ = 0; k_ < 4; ++k_) e_[k_] -= dl_; } \
            _Pragma("unroll") for (int k_ = 0; k_ < 4; ++k_) e_[k_] = __builtin_amdgcn_exp2f(e_[k_]); \
            l[QG] += (e_[0] + e_[1]) + (e_[2] + e_[3]); \
            u32x4 pw_ = {0u, 0u, 0u, 0u}; if ((I0) == 0) { pw_.x = pk2(e_[0], e_[1]); pw_.y = pk2(e_[2], e_[3]); } else { pw_.z = pk2(e_[0], e_[1]); pw_.w = pk2(e_[2], e_[3]); } \
            PB = __builtin_bit_cast(bf16x8, pw_); } while (0)
        bool sp0 = false, sp1 = false;
        if (MODE == 1) { sp0 = local && (ksub == 1); sp1 = local && (ksub == 0); }
        bf16x8 p00, p01;
        if (sp0) { NA_SPARSE(0, 0, p00); p01 = p00; }
        else { NA_MASK(0); softmax_step(sc[0], m[0], l[0], o[0][0], o[0][1]); p00 = pack8(sc[0], 0); p01 = pack8(sc[0], 1); }
        asm volatile("s_waitcnt lgkmcnt(0)" : "+v"(vt0), "+v"(vt1), "+v"(vt2), "+v"(vt3), "+v"(vt4), "+v"(vt5), "+v"(vt6), "+v"(vt7) :: "memory");
        const u32x4 a00 = {vt0.x, vt0.y, vt1.x, vt1.y}, a01 = {vt2.x, vt2.y, vt3.x, vt3.y}, a10 = {vt4.x, vt4.y, vt5.x, vt5.y}, a11 = {vt6.x, vt6.y, vt7.x, vt7.y};
        __builtin_amdgcn_s_setprio(1);
        o[0][0] = __builtin_amdgcn_mfma_f32_32x32x16_bf16(__builtin_bit_cast(bf16x8, a00), p00, o[0][0], 0, 0, 0);
        o[0][1] = __builtin_amdgcn_mfma_f32_32x32x16_bf16(__builtin_bit_cast(bf16x8, a10), p00, o[0][1], 0, 0, 0);
        if (!sp0) {
          o[0][0] = __builtin_amdgcn_mfma_f32_32x32x16_bf16(__builtin_bit_cast(bf16x8, a01), p01, o[0][0], 0, 0, 0);
          o[0][1] = __builtin_amdgcn_mfma_f32_32x32x16_bf16(__builtin_bit_cast(bf16x8, a11), p01, o[0][1], 0, 0, 0); }
        __builtin_amdgcn_s_setprio(0);
        __builtin_amdgcn_sched_barrier(0);
        bf16x8 p10, p11;
        if (sp1) { NA_SPARSE(1, 12, p11); p10 = p11; }
        else { NA_MASK(1); softmax_step(sc[1], m[1], l[1], o[1][0], o[1][1]); p10 = pack8(sc[1], 0); p11 = pack8(sc[1], 1); }
        __builtin_amdgcn_s_setprio(1);
        o[1][0] = __builtin_amdgcn_mfma_f32_32x32x16_bf16(__builtin_bit_cast(bf16x8, a01), p11, o[1][0], 0, 0, 0);
        o[1][1] = __builtin_amdgcn_mfma_f32_32x32x16_bf16(__builtin_bit_cast(bf16x8, a11), p11, o[1][1], 0, 0, 0);
        if (!sp1) {
          o[1][0] = __builtin_amdgcn_mfma_f32_32x32x16_bf16(__builtin_bit_cast(bf16x8, a00), p10, o[1][0], 0, 0, 0);
          o[1][1] = __builtin_amdgcn_mfma_f32_32x32x16_bf16(__builtin_bit_cast(bf16x8, a10), p10, o[1][1], 0, 0, 0); }
        __builtin_amdgcn_s_setprio(0);
#undef NA_SPARSE
#undef NA_MASK
        }
        if (t + 1 < nT) { ATT_WRITE((t + 1) & 1, kB0, kB1, vB); if (t + 3 < nT) ATT_LOAD(t + 3, kB0, kB1, vB); }
        __syncthreads(); }
        if (t0 + 1 < nT) { const int t = t0 + 1;
        const LAS bf16_t* Kl = (const LAS bf16_t*)(lds + (t & 1) * ATT_BUF + ATT_K_OFF);
        bool local = false, skip = false; int krow = 0;
        if (MODE == 1) { local = t < n0; krow = kr_lo + t; skip = local && (krow < rs || krow >= rs + 8); }
        if (!skip) {
        f32x16 sc[2];
#pragma unroll
        for (int i = 0; i < 16; ++i) { sc[0][i] = -m[0]; sc[1][i] = -m[1]; }
        bf16x8 kf[NS];
#pragma unroll
        for (int st = 0; st < NS; ++st) kf[st] = *(const LAS bf16x8*)(Kl + (32 * ksub + r32) * KS + 16 * st + 8 * hi);
        __builtin_amdgcn_sched_barrier(0);
        __builtin_amdgcn_s_setprio(1);
#pragma unroll
        for (int st = 0; st < NS; ++st) sc[0] = __builtin_amdgcn_mfma_f32_32x32x16_bf16(kf[st], qf[0][st], sc[0], 0, 0, 0);
#pragma unroll
        for (int st = 0; st < NS; ++st) sc[1] = __builtin_amdgcn_mfma_f32_32x32x16_bf16(kf[st], qf[1][st], sc[1], 0, 0, 0);
        __builtin_amdgcn_s_setprio(0);
        __builtin_amdgcn_sched_barrier(0);
        u32x2 vt0, vt1, vt2, vt3, vt4, vt5, vt6, vt7;
        { const unsigned va = (unsigned)(size_t)(lds + (t & 1) * ATT_BUF + ATT_V_OFF) + vtr_off;
          asm volatile("ds_read_b64_tr_b16 %0, %8\n\tds_read_b64_tr_b16 %1, %8 offset:1536\n\tds_read_b64_tr_b16 %2, %8 offset:3072\n\tds_read_b64_tr_b16 %3, %8 offset:4608\n\t"
                       "ds_read_b64_tr_b16 %4, %8 offset:64\n\tds_read_b64_tr_b16 %5, %8 offset:1600\n\tds_read_b64_tr_b16 %6, %8 offset:3136\n\tds_read_b64_tr_b16 %7, %8 offset:4672"
                       : "=&v"(vt0), "=&v"(vt1), "=&v"(vt2), "=&v"(vt3), "=&v"(vt4), "=&v"(vt5), "=&v"(vt6), "=&v"(vt7) : "v"(va) : "memory"); }
        __builtin_amdgcn_sched_barrier(0);
#define NA_MASK(QG) do { if (MODE == 1) { if (local) { const LAS float* brow = Bl + (krow - qr + 7) * 32; \
            const int qc = 32 * (QG) + r32, cs0 = qc - 8 < 0 ? 0 : (qc - 8 > 48 ? 48 : qc - 8); \
            const int d0 = 32 * ksub + 4 * hi - cs0; const LAS float* bp = brow + (32 * ksub + 4 * hi - qc + 15); float bvv[16]; \
            _Pragma("unroll") for (int i = 0; i < 16; ++i) bvv[i] = bp[8 * (i >> 2) + (i & 3)]; \
            asm volatile("" : "+v"(bvv[0]), "+v"(bvv[1]), "+v"(bvv[2]), "+v"(bvv[3]), "+v"(bvv[4]), "+v"(bvv[5]), "+v"(bvv[6]), "+v"(bvv[7]), "+v"(bvv[8]), "+v"(bvv[9]), "+v"(bvv[10]), "+v"(bvv[11]), "+v"(bvv[12]), "+v"(bvv[13]), "+v"(bvv[14]), "+v"(bvv[15])); \
            _Pragma("unroll") for (int i = 0; i < 16; ++i) { const int c = 8 * (i >> 2) + (i & 3); sc[QG][i] = ((unsigned)(d0 + c) < 16u) ? sc[QG][i] + bvv[i] : -1e30f; } } } } while (0)
#define NA_SPARSE(QG, I0, PB) do { const LAS float* brow = Bl + (krow - qr + 7) * 32; \
            const int qc = 32 * (QG) + r32, cs0 = qc - 8 < 0 ? 0 : (qc - 8 > 48 ? 48 : qc - 8); \
            const int d0 = 32 * ksub + 4 * hi - cs0; const LAS float* bp = brow + (32 * ksub + 4 * hi - qc + 15); float e_[4]; \
            float b_[4]; _Pragma("unroll") for (int k_ = 0; k_ < 4; ++k_) { const int i_ = (I0) + k_; b_[k_] = bp[8 * (i_ >> 2) + (i_ & 3)]; } \
            asm volatile("" : "+v"(b_[0]), "+v"(b_[1]), "+v"(b_[2]), "+v"(b_[3])); \
            _Pragma("unroll") for (int k_ = 0; k_ < 4; ++k_) { const int i_ = (I0) + k_, c_ = 8 * (i_ >> 2) + (i_ & 3); e_[k_] = ((unsigned)(d0 + c_) < 16u) ? sc[QG][i_] + b_[k_] : -1e30f; } \
            float mx_ = fmaxf(max3f(e_[0], e_[1], e_[2]), e_[3]); \
            if (__builtin_amdgcn_ballot_w64(mx_ > 8.f) != 0ull) { mx_ = pg8::xmax32(mx_); const float dl_ = fmaxf(mx_, 0.f), al_ = __builtin_amdgcn_exp2f(-dl_); \
                m[QG] += dl_; l[QG] *= al_; o[QG][0] = o[QG][0] * al_; o[QG][1] = o[QG][1] * al_; _Pragma("unroll") for (int k_ = 0; k_ < 4; ++k_) e_[k_] -= dl_; } \
            _Pragma("unroll") for (int k_ = 0; k_ < 4; ++k_) e_[k_] = __builtin_amdgcn_exp2f(e_[k_]); \
            l[QG] += (e_[0] + e_[1]) + (e_[2] + e_[3]); \
            u32x4 pw_ = {0u, 0u, 0u, 0u}; if ((I0) == 0) { pw_.x = pk2(e_[0], e_[1]); pw_.y = pk2(e_[2], e_[3]); } else { pw_.z = pk2(e_[0], e_[1]); pw_.w = pk2(e_[2], e_[3]); } \
            PB = __builtin_bit_cast(bf16x8, pw_); } while (0)
        bool sp0 = false, sp1 = false;
        if (MODE == 1) { sp0 = local && (ksub == 1); sp1 = local && (ksub == 0); }
        bf16x8 p00, p01;
        if (sp0) { NA_SPARSE(0, 0, p00); p01 = p00; }
        else { NA_MASK(0); softmax_step(sc[0], m[0], l[0], o[0][0], o[0][1]); p00 = pack8(sc[0], 0); p01 = pack8(sc[0], 1); }
        asm volatile("s_waitcnt lgkmcnt(0)" : "+v"(vt0), "+v"(vt1), "+v"(vt2), "+v"(vt3), "+v"(vt4), "+v"(vt5), "+v"(vt6), "+v"(vt7) :: "memory");
        const u32x4 a00 = {vt0.x, vt0.y, vt1.x, vt1.y}, a01 = {vt2.x, vt2.y, vt3.x, vt3.y}, a10 = {vt4.x, vt4.y, vt5.x, vt5.y}, a11 = {vt6.x, vt6.y, vt7.x, vt7.y};
        __builtin_amdgcn_s_setprio(1);
        o[0][0] = __builtin_amdgcn_mfma_f32_32x32x16_bf16(__builtin_bit_cast(bf16x8, a00), p00, o[0][0], 0, 0, 0);
        o[0][1] = __builtin_amdgcn_mfma_f32_32x32x16_bf16(__builtin_bit_cast(bf16x8, a10), p00, o[0][1], 0, 0, 0);
        if (!sp0) {
          o[0][0] = __builtin_amdgcn_mfma_f32_32x32x16_bf16(__builtin_bit_cast(bf16x8, a01), p01, o[0][0], 0, 0, 0);
          o[0][1] = __builtin_amdgcn_mfma_f32_32x32x16_bf16(__builtin_bit_cast(bf16x8, a11), p01, o[0][1], 0, 0, 0); }
        __builtin_amdgcn_s_setprio(0);
        __builtin_amdgcn_sched_barrier(0);
        bf16x8 p10, p11;
        if (sp1) { NA_SPARSE(1, 12, p11); p10 = p11; }
        else { NA_MASK(1); softmax_step(sc[1], m[1], l[1], o[1][0], o[1][1]); p10 = pack8(sc[1], 0); p11 = pack8(sc[1], 1); }
        __builtin_amdgcn_s_setprio(1);
        o[1][0] = __builtin_amdgcn_mfma_f32_32x32x16_bf16(__builtin_bit_cast(bf16x8, a01), p11, o[1][0], 0, 0, 0);
        o[1][1] = __builtin_amdgcn_mfma_f32_32x32x16_bf16(__builtin_bit_cast(bf16x8, a11), p11, o[1][1], 0, 0, 0);
        if (!sp1) {
          o[1][0] = __builtin_amdgcn_mfma_f32_32x32x16_bf16(__builtin_bit_cast(bf16x8, a00), p10, o[1][0], 0, 0, 0);
          o[1][1] = __builtin_amdgcn_mfma_f32_32x32x16_bf16(__builtin_bit_cast(bf16x8, a10), p10, o[1][1], 0, 0, 0); }
        __builtin_amdgcn_s_setprio(0);
#undef NA_SPARSE
#undef NA_MASK
        }
        if (t + 1 < nT) { ATT_WRITE((t + 1) & 1, kA0, kA1, vA); if (t + 3 < nT) ATT_LOAD(t + 3, kA0, kA1, vA); }
        __syncthreads(); }
    }
    }
#undef ATT_WRITE
#undef ATT_LOAD
    LAS float* mg = (LAS float*)lds + (size_t)pg * (68 * 64) + lane;
    if (ksub == 1) {
#pragma unroll
        for (int qg = 0; qg < 2; ++qg) { mg[(qg * 34 + 0) * 64] = m[qg]; mg[(qg * 34 + 1) * 64] = l[qg];
#pragma unroll
            for (int dt = 0; dt < 2; ++dt)
#pragma unroll
                for (int i = 0; i < 16; ++i) mg[(qg * 34 + 2 + dt * 16 + i) * 64] = o[qg][dt][i]; }
    }
    __syncthreads();
    if (ksub == 0) {
#pragma unroll
        for (int qg = 0; qg < 2; ++qg) {
            const float m1 = mg[(qg * 34 + 0) * 64], l1 = mg[(qg * 34 + 1) * 64];
            const float mt = fmaxf(m[qg], m1), a0 = __builtin_amdgcn_exp2f(m[qg] - mt), a1 = __builtin_amdgcn_exp2f(m1 - mt);
            float lt = l[qg] * a0 + l1 * a1; lt = pg8::xadd32(lt);
            const float inv = 1.f / lt, c0 = a0 * inv, c1 = a1 * inv;
            bf16_t* op = O + (size_t)(pg * 64 + qg * 32 + r32) * ostride + 4 * hi;
#pragma unroll
            for (int dt = 0; dt < 2; ++dt)
#pragma unroll
                for (int g = 0; g < 4; ++g) {
                    float v[4];
#pragma unroll
                    for (int e = 0; e < 4; ++e) v[e] = o[qg][dt][4 * g + e] * c0 + mg[(qg * 34 + 2 + dt * 16 + 4 * g + e) * 64] * c1;
                    u32x2 w; w.x = pk2(v[0], v[1]); w.y = pk2(v[2], v[3]); *(u32x2*)(op + 32 * dt + 8 * g) = w; }
        }
    }
}

DI void phase_mla_attn(const Ctx& C, ArgsP A) {
    const bf16_t* QF = (const bf16_t*)(A->ws + WS_QF); const bf16_t* KF = (const bf16_t*)(A->ws + WS_KF); const bf16_t* VF = (const bf16_t*)(A->ws + WS_VF);
    bf16_t* CAT = (bf16_t*)(A->ws + WS_CAT);
    const int bx = blockIdx.x;
    for (int u = bx; u < 256; u += C.G) {
        const int x = u & 7, j = u >> 3, bh = 2 * x + (j >> 4), b = bh >> 3, h = bh & 7, qb = j & 15;
        const size_t qrow = (size_t)NPR + (size_t)b * 4096 + (size_t)qb * 256, krow = (size_t)NPR + (size_t)b * 4608;
        attn_unit<96, 0, 768, 768, 512, 1024>(C.lds, QF + qrow * 768 + h * 96, KF + krow * 768 + h * 96, VF + krow * 512 + h * 64, 72, nullptr, nullptr, 72, CAT + qrow * 1024 + 512 + h * 64, 0, 0);
    }
    for (int u = bx; u < 128; u += C.G) {
        const int b = u >> 3, h = u & 7; const size_t row = (size_t)b * 256;
        attn_unit<96, 0, 768, 768, 512, 1024>(C.lds, QF + row * 768 + h * 96, KF + row * 768 + h * 96, VF + row * 512 + h * 64, 4, nullptr, nullptr, 4, CAT + row * 1024 + 512 + h * 64, 0, 0);
    }
}
DI void phase_na_attn(const Ctx& C, ArgsP A) {
    const bf16_t* Q1 = (const bf16_t*)(A->ws + WS_Q1); const bf16_t* K1 = (const bf16_t*)(A->ws + WS_K1); const bf16_t* V1 = (const bf16_t*)(A->ws + WS_V1);
    const bf16_t* CK1 = (const bf16_t*)(A->ws + WS_CK1); const bf16_t* CV1 = (const bf16_t*)(A->ws + WS_CV1);
    bf16_t* CAT = (bf16_t*)(A->ws + WS_CAT);
    const float* rel_bias = A->in[33];
    LAS float* Bl = (LAS float*)(C.lds + ATT_B_OFF);
    const int bx = blockIdx.x;
    for (int u = bx; u < 512; u += C.G) {
        const int x = u & 7, jj = u >> 3, bh = 4 * x + (jj >> 4), b = bh >> 4, h = bh & 15, rg = jj & 15, r0 = 4 * rg;
        const int kr_lo = r0 - 4 < 0 ? 0 : (r0 - 4 > 56 ? 56 : r0 - 4);
        const int rs_hi = r0 + 3 - 4 < 0 ? 0 : (r0 + 3 - 4 > 56 ? 56 : r0 + 3 - 4);
        const int nLocal = rs_hi + 8 - kr_lo;
        float bias_v = 0.f; { const int i = C.tid, dr = i >> 5, dc = i & 31; if (i < 15 * 32 && dc < 31) bias_v = rel_bias[(size_t)h * 465 + dr * 31 + dc] * LOG2E; }
        __syncthreads();
        if (C.tid < 15 * 32) Bl[C.tid] = bias_v;
        const size_t qrow = (size_t)NPR + (size_t)b * 4096 + (size_t)r0 * 64, krow = (size_t)NPR + (size_t)b * 4096 + (size_t)kr_lo * 64, crow = (size_t)b * 512;
        attn_unit<64, 1, 1024, 1024, 1024, 1024>(C.lds, Q1 + qrow * 1024 + h * 64, K1 + krow * 1024 + h * 64, V1 + krow * 1024 + h * 64, nLocal, CK1 + crow * 1024 + h * 64, CV1 + crow * 1024 + h * 64, nLocal + 8,
                         CAT + qrow * 1024 + h * 64, kr_lo, r0);
    }
    for (int u = bx; u < 256; u += C.G) {
        const int b = u >> 4, h = u & 15; const size_t row = (size_t)b * 256;
        attn_unit<64, 0, 1024, 1024, 1024, 1024>(C.lds, Q1 + row * 1024 + h * 64, K1 + row * 1024 + h * 64, V1 + row * 1024 + h * 64, 4, nullptr, nullptr, 4, CAT + row * 1024 + h * 64, 0, 0);
    }
}

#ifndef PH_MASK
#define PH_MASK 0x3ffff
#endif
#define IN(k) (((PH_MASK >> (k)) & 1) && lo <= (k) && (k) < hi)
#define SEAM(k) do { if (IN(k) && IN((k) + 1)) xcd_barrier(bar); } while (0)
template <int layer> DI void run_layer(const Ctx& C, const XcdBarrier& bar, const int lo, const int hi) {
    const int bx = blockIdx.x, G = C.G;
        const int pb = layer ? 11 : 1;
        if (layer == 0) if (IN(pb)) for (int rep = 0; rep < REP_EW; ++rep) { ArgsP A = get_args(); const float* mod = (const float*)(A->ws + WS_MOD) + (size_t)layer * 3 * 6144;
            phase_modulate(C, A, layer ? A->out : A->in[0], layer ? A->out + (size_t)NPR * DM : A->in[1], layer ? A->in[26] : A->in[10], mod, 0, 1024); }
        if (layer == 0) SEAM(pb);
        if (layer == 0) {
            if (IN(2)) { ArgsP A = get_args(); unsigned char* ws = A->ws;
                pg8::Gemm g{(const bf16_t*)(ws + WS_H), (const bf16_t*)(ws + WS_WIN0), NTOK, 1024, 1024}; pg8::StaticOrder S; S.init(64 * 256, 1024, G, bx);
                pg8::EpiF32<true> E{(float*)(ws + WS_Y0), 1024}; pg8::gemm_phase<pg8::EpiF32<true>, pg8::StaticOrder, true, true, true>(C.lds, g, S, E); }
            SEAM(2);
            if (IN(3)) for (int rep = 0; rep < REP_EW; ++rep) { ArgsP A = get_args(); phase_post_in0(C, A); }
            SEAM(3);
            if (IN(4)) {
                { ArgsP A = get_args(); unsigned char* ws = A->ws;
                  pg8::Gemm g{(const bf16_t*)(ws + WS_QN), (const bf16_t*)(ws + WS_WQUP), NTOK, 768, 256}; pg8::StaticOrder S; S.init(NTOK, 768, G, bx);
                  pg8::EpiB<0> E{(bf16_t*)(ws + WS_QRAW), 768}; pg8::gemm_phase<pg8::EpiB<0>, pg8::StaticOrder, true, true>(C.lds, g, S, E); }
                { ArgsP A = get_args(); unsigned char* ws = A->ws;
                  pg8::Gemm g{(const bf16_t*)(ws + WS_CKVB), (const bf16_t*)(ws + WS_WKVUP), NROWC, 1024, 128}; pg8::StaticOrder S; S.init(NROWC, 1024, G, (bx + G - 144) % G);
                  pg8::EpiB<0> E{(bf16_t*)(ws + WS_KVRAW), 1024}; pg8::gemm_phase<pg8::EpiB<0>, pg8::StaticOrder, true, true>(C.lds, g, S, E); }
                { ArgsP A = get_args(); unsigned char* ws = A->ws;
                  pg8::Gemm g{(const bf16_t*)(ws + WS_POOLED), (const bf16_t*)(ws + WS_WPOOL), NTOK, 512, 512}; pg8::StaticOrder S; S.init(NTOK, 512, G, (bx + G - 96) % G);
                  pg8::EpiB<0> E{(bf16_t*)(ws + WS_CAT), 1024}; pg8::gemm_phase<pg8::EpiB<0>, pg8::StaticOrder, true, true>(C.lds, g, S, E); }
                { ArgsP A = get_args(); unsigned char* ws = A->ws;
                  deferred_transposes<0>(C, A, 192);
                  if (bx >= 192) gemv_sh_unit<false>(C, A->in[12], 4096, (const float*)(ws + WS_MOD) + 3072, (float*)(ws + WS_SHW1), bx - 192); }
            }
            SEAM(4);
            if (IN(5)) for (int rep = 0; rep < REP_EW; ++rep) { ArgsP A = get_args(); phase_mla_finish(C, A); }
            SEAM(5);
            if (IN(6)) for (int rep = 0; rep < REP_ATT; ++rep) { ArgsP A = get_args(); phase_mla_attn(C, A);
                __syncthreads();
                deferred_transposes<1>(C, A, 128);
                if (bx >= 128) { unsigned char* ws = A->ws; const float* mod1 = (const float*)(ws + WS_MOD) + (size_t)3 * 6144; const int uu = bx - 128;
                    if (uu < 48) gemv_sh_unit<true>(C, A->in[30], 3072, mod1 + 0, (float*)(ws + WS_SHWIN), uu);
                    else if (uu < 112) gemv_sh_unit<false>(C, A->in[28], 4096, mod1 + 3072, (float*)(ws + WS_SHW1) + 3 * 4096, uu - 48); } }
            SEAM(6);
        } else {
            if (IN(12)) { ArgsP A = get_args(); unsigned char* ws = A->ws;
                pg8::Gemm g{(const bf16_t*)(ws + WS_H), (const bf16_t*)(ws + WS_WIN1), NTOK, 3072, 1024}; pg8::StaticOrder S; S.init(64 * 256, 3072, G, bx);
                pg8::EpiQKV<true> E{(bf16_t*)(ws + WS_Q1), A->out + OUT_NAK, (const float*)(ws + WS_MOD + 256 * 1024), 0.125f * LOG2E, (const float*)(ws + WS_ROWP), (const float*)(ws + WS_SHWIN)};
                pg8::gemm_phase<pg8::EpiQKV<true>, pg8::StaticOrder, true, true, true>(C.lds, g, S, E); }
            SEAM(12);
            if (IN(13)) for (int rep = 0; rep < REP_ATT; ++rep) { ArgsP A = get_args(); phase_na_attn(C, A); }
            SEAM(13);
        }
        const int po = layer ? 14 : 7;
        if (IN(po)) { ArgsP A = get_args(); unsigned char* ws = A->ws; const float* mod = (const float*)(ws + WS_MOD) + (size_t)layer * 3 * 6144;
            pg8::Gemm g{(const bf16_t*)(ws + WS_CAT), (const bf16_t*)(ws + (layer ? WS_WOUT1 : WS_WOUT0)), NTOK, 1024, 1024}; pg8::StaticOrder S; S.init(64 * 256, 1024, G, bx);
            pg8::EpiRes<true, true> E{layer ? A->out : A->in[0], layer ? A->out + (size_t)NPR * DM : A->in[1], A->out, mod + 2048,
                                (bf16_t*)(ws + WS_H), layer ? A->in[27] : A->in[11], mod + 4096, (float*)(ws + WS_ROWP)};
            pg8::gemm_phase<pg8::EpiRes<true, true>, pg8::StaticOrder, true, true, true>(C.lds, g, S, E); }
        SEAM(po);
        if (IN(po + 2)) for (int rep = 0; rep < REP_MLP1; ++rep) { ArgsP A = get_args(); unsigned char* ws = A->ws;
            pg8::Gemm g{(const bf16_t*)(ws + WS_H), (const bf16_t*)(ws + (layer ? WS_W1_1 : WS_W1_0)), NTOK, FF, 1024}; pg8::StaticOrder S; S.init(NTOK, FF, G, bx);
            pg8::EpiMlp1 E{(bf16_t*)(ws + WS_U), FF, (const float*)(ws + WS_ROWP), (const float*)(ws + WS_SHW1) + (size_t)layer * 3 * 4096}; pg8::gemm_phase<pg8::EpiMlp1, pg8::StaticOrder, true, true>(C.lds, g, S, E); }
        SEAM(po + 2);
        if (IN(po + 3)) { ArgsP A = get_args(); unsigned char* ws = A->ws; const float* mod = (const float*)(ws + WS_MOD) + (size_t)layer * 3 * 6144;
            pg8::Gemm g{(const bf16_t*)(ws + WS_U), (const bf16_t*)(ws + (layer ? WS_W2_1 : WS_W2_0)), NTOK, 1024, FF}; pg8::StaticOrder S; S.init(64 * 256, 1024, G, bx);
            if (layer == 0) { pg8::EpiRes<true, true> E{A->out, A->out + (size_t)NPR * DM, A->out, mod + 5120, (bf16_t*)(ws + WS_H), A->in[26], mod + (size_t)3 * 6144 + 1024, (float*)(ws + WS_ROWP)};
                pg8::gemm_phase<pg8::EpiRes<true, true>, pg8::StaticOrder, true, true, true>(C.lds, g, S, E); deferred_transposes<2>(C, A, 0); }
            else { pg8::EpiRes<false, true> E{A->out, A->out + (size_t)NPR * DM, A->out, mod + 5120, nullptr, nullptr, nullptr, nullptr};
                pg8::gemm_phase<pg8::EpiRes<false, true>, pg8::StaticOrder, true, true, true>(C.lds, g, S, E); } }
        SEAM(po + 3);
    }

constexpr int NPHASE = 18;
__global__ void __launch_bounds__(NTHREADS, 2) fwd_kernel(Args args) {
    extern __shared__ __attribute__((aligned(16))) unsigned char lds_raw[];
    Ctx C;
    C.lds = (LAS unsigned char*)lds_raw;
    C.tid = threadIdx.x; C.lane = C.tid & 63; C.wave = __builtin_amdgcn_readfirstlane(C.tid >> 6); C.G = gridDim.x;
    const int lo = args.ph_lo, hi = args.ph_hi;
    volatile LAS unsigned* bst = (volatile LAS unsigned*)(C.lds + 131072 + 1024);
    if (C.tid < 2) bst[C.tid] = 0u;
    __syncthreads();
    XcdBarrier bar; bar.bar = (unsigned*)args.ws; bar.x = 0; bar.st = bst;
    if (hi - lo > 1) bar = xcd_barrier_post((unsigned*)args.ws, bst);
    if (hi > 1000) cg::this_grid().sync();
    if (IN(0)) for (int rep = 0; rep < REP_P0; ++rep) { ArgsP A = get_args(); phase_prologue(C, A); if (rep + 1 < REP_P0) __syncthreads(); }
    for (int rep = 0; rep < REP_SYNC; ++rep) cg::this_grid().sync();
    SEAM(0);
    run_layer<0>(C, bar, lo, hi);
    run_layer<1>(C, bar, lo, hi);
#undef IN
#undef SEAM
}

extern "C" void kernel_launch(void* const* d_in, const int* in_sizes, int n_in, void* d_out, int out_size, void* d_ws, size_t ws_size, hipStream_t stream) {
    static int grid = 0;
    if (grid == 0) {
        int dev = 0, cus = 0, per_cu = 0;
        if (hipGetDevice(&dev) != hipSuccess || hipDeviceGetAttribute(&cus, hipDeviceAttributeMultiprocessorCount, dev) != hipSuccess) { fprintf(stderr, "kernel_launch: device query failed\n"); grid = -1; return; }
        if (hipFuncSetAttribute((const void*)fwd_kernel, hipFuncAttributeMaxDynamicSharedMemorySize, LDS_BYTES) != hipSuccess) { fprintf(stderr, "kernel_launch: hipFuncSetAttribute failed\n"); grid = -1; return; }
        if (hipOccupancyMaxActiveBlocksPerMultiprocessor(&per_cu, (const void*)fwd_kernel, NTHREADS, LDS_BYTES) != hipSuccess || per_cu < 1) { fprintf(stderr, "kernel_launch: occupancy query gave %d\n", per_cu); per_cu = 1; }
        (void)hipGetLastError();
        grid = cus;
    }
    if (grid < 0) return;
    Args a{};
    for (int i = 0; i < 35; ++i) a.in[i] = (const float*)d_in[i];
    a.out = (float*)d_out; a.ws = (unsigned char*)d_ws;
#if MK_PER_PHASE
#ifndef NPH_RUN
#define NPH_RUN NPHASE
#endif
    for (int p = 0; p < NPH_RUN; ++p) { a.ph_lo = p; a.ph_hi = p + 1; hipLaunchKernelGGL(fwd_kernel, dim3(grid), dim3(NTHREADS), LDS_BYTES, stream, a); }
#else
    if (hipMemsetAsync(d_ws, 0, 16384, stream) != hipSuccess) { fprintf(stderr, "kernel_launch: hipMemsetAsync failed\n"); return; }
    a.ph_lo = 0; a.ph_hi = NPHASE;
    void* kargs[] = {&a};
    hipError_t e = hipLaunchCooperativeKernel((const void*)fwd_kernel, dim3(grid), dim3(NTHREADS), kargs, LDS_BYTES, stream);
    if (e != hipSuccess) fprintf(stderr, "kernel_launch: cooperative launch failed: %s (grid %d)\n", hipGetErrorString(e), grid);
#endif
}
```
